# Optimizing an MI355X kernel written in HIP

```python
import jax, jax.numpy as jnp
from jax import lax
import numpy as np

D_MODEL = 2048
BATCH = 4
SEQ = 2048
DEPTH = 1

D_MIX = D_MODEL
HGRN_HEADS = 8
HGRN_DK = 128
HGRN_DV = 128
HGRN_WIDTH = HGRN_HEADS * HGRN_DV
HGRN_KWIDTH = HGRN_HEADS * HGRN_DK
HGRN_CHUNK = 64
MLA_HEADS = 8
MLA_Q_LORA = 512
MLA_KV_LORA = 256
MLA_NOPE = 128
MLA_ROPE = 64
MLA_V = 128
MLA_QK = MLA_NOPE + MLA_ROPE
MLA_WIDTH = MLA_HEADS * MLA_V
ROPE_BASE = 10000.0
ATTN_BLOCK = 128
N_EXPERTS = 16
EC_CAPACITY = 2
EXPERT_FF = 2048
EPS = 1e-6
IN_SIZES = (HGRN_KWIDTH, HGRN_KWIDTH, HGRN_KWIDTH, HGRN_WIDTH, HGRN_WIDTH, MLA_Q_LORA, MLA_KV_LORA, MLA_ROPE)
D_IN = HGRN_KWIDTH * 3 + HGRN_WIDTH * 2 + MLA_Q_LORA + MLA_KV_LORA + MLA_ROPE

kernel_name = "hymba_hgrn2_mla_expert_choice_encoder_layer"


def _split_points():
    pts, acc = [], 0
    for s in IN_SIZES[:-1]:
        acc += s
        pts.append(acc)
    return pts


def rmsnorm(x, g):
    xf = x.astype(jnp.float32)
    y = xf * lax.rsqrt(jnp.mean(xf * xf, axis=-1, keepdims=True) + EPS)
    return (y * g.astype(jnp.float32)).astype(x.dtype)


def rope_tables(positions):
    inv_freq = 1.0 / (ROPE_BASE ** (jnp.arange(0, MLA_ROPE, 2, dtype=jnp.float32) / MLA_ROPE))
    ang = positions.astype(jnp.float32)[..., None] * inv_freq
    return jnp.cos(ang)[:, :, None, :], jnp.sin(ang)[:, :, None, :]


def apply_rope(x, cos, sin):
    xf = x.astype(jnp.float32)
    half = MLA_ROPE // 2
    x1, x2 = xf[..., :half], xf[..., half:]
    return jnp.concatenate([x1 * cos - x2 * sin, x2 * cos + x1 * sin], axis=-1).astype(x.dtype)


def hgrn2_bidirectional(q, i, zf_fwd, zf_bwd, lb_fwd, lb_bwd):
    B, S, _ = q.shape
    f32 = jnp.float32
    L = HGRN_CHUNK
    N = S // L

    def log_forget(z, lb):
        lb = lb.astype(f32)
        return jnp.log(lb + (1.0 - lb) * jax.nn.sigmoid(z.astype(f32)))

    qf = q.astype(f32)
    vf = i.astype(f32)
    q2 = jnp.concatenate([qf, qf[:, ::-1]], axis=0)
    v2 = jnp.concatenate([vf, vf[:, ::-1]], axis=0)
    g2 = jnp.concatenate([log_forget(zf_fwd, lb_fwd), log_forget(zf_bwd, lb_bwd)[:, ::-1]], axis=0)
    k2 = -jnp.expm1(g2)

    def to_chunks(t, d):
        return t.reshape(2 * B, N, L, HGRN_HEADS, d).transpose(1, 0, 3, 2, 4)

    xs = (to_chunks(q2, HGRN_DK), to_chunks(k2, HGRN_DK), to_chunks(v2, HGRN_DV), to_chunks(g2, HGRN_DK))
    mask = jnp.tril(jnp.ones((L, L), dtype=bool))[:, :, None]

    def step(state, inp):
        qc, kc, vc, gc = inp
        b = jnp.cumsum(gc, axis=2)
        o_inter = jnp.einsum('zhtk,zhkv->zhtv', qc * jnp.exp(b), state)
        diff = b[:, :, :, None, :] - b[:, :, None, :, :]
        decay = jnp.exp(jnp.where(mask, diff, -jnp.inf))
        att = jnp.einsum('zhtsk,zhsk->zhts', decay * qc[:, :, :, None, :], kc)
        o = o_inter + jnp.einsum('zhts,zhsv->zhtv', att, vc)
        b_last = b[:, :, -1:, :]
        state = jnp.exp(b_last[:, :, 0, :])[..., None] * state + \
            jnp.einsum('zhsk,zhsv->zhkv', kc * jnp.exp(b_last - b), vc)
        return state, o

    state0 = jnp.zeros((2 * B, HGRN_HEADS, HGRN_DK, HGRN_DV), f32)
    _, o = lax.scan(step, state0, xs)
    o = o.transpose(1, 0, 3, 2, 4).reshape(2 * B, S, HGRN_HEADS, HGRN_DV)
    return o[:B] + o[B:, ::-1]


def mla_bidirectional(cq, ckv, kpe, positions, qa_norm_g, w_uq, kva_norm_g, w_ukv, q_head_g, k_head_g):
    B, S, _ = cq.shape
    q = (rmsnorm(cq, qa_norm_g) @ w_uq).reshape(B, S, MLA_HEADS, MLA_QK)
    kv = (rmsnorm(ckv, kva_norm_g) @ w_ukv).reshape(B, S, MLA_HEADS, MLA_NOPE + MLA_V)
    k_nope, v = kv[..., :MLA_NOPE], kv[..., MLA_NOPE:]
    k = jnp.concatenate([k_nope, jnp.broadcast_to(kpe[:, :, None, :], (B, S, MLA_HEADS, MLA_ROPE))], axis=-1)
    q = rmsnorm(q, q_head_g)
    k = rmsnorm(k, k_head_g)
    cos, sin = rope_tables(positions)
    q = jnp.concatenate([q[..., :MLA_NOPE], apply_rope(q[..., MLA_NOPE:], cos, sin)], axis=-1)
    k = jnp.concatenate([k[..., :MLA_NOPE], apply_rope(k[..., MLA_NOPE:], cos, sin)], axis=-1)

    nb = S // ATTN_BLOCK
    scale = MLA_QK ** -0.5
    qb = q.reshape(B, nb, ATTN_BLOCK, MLA_HEADS, MLA_QK).transpose(1, 0, 3, 2, 4)
    kt = k.transpose(0, 2, 1, 3)
    vt = v.transpose(0, 2, 1, 3)

    def attend(qblk):
        s = jnp.einsum('bhqd,bhkd->bhqk', qblk, kt).astype(jnp.float32) * scale
        p = jax.nn.softmax(s, axis=-1).astype(vt.dtype)
        return jnp.einsum('bhqk,bhkd->bhqd', p, vt)

    o = lax.map(attend, qb)
    return o.transpose(1, 0, 3, 2, 4).reshape(B, S, MLA_WIDTH)


def expert_choice_ffn(h, w_router, w_gate, w_up, w_down):
    B, S, D = h.shape
    cap = EC_CAPACITY * S // N_EXPERTS
    aff = jax.nn.softmax((h @ w_router).astype(jnp.float32), axis=-1)
    gates, idx = lax.top_k(aff.transpose(0, 2, 1), cap)
    xe = jax.vmap(lambda hb, ib: hb[ib])(h, idx)
    a = jnp.einsum('becd,edf->becf', xe, w_gate)
    u = jnp.einsum('becd,edf->becf', xe, w_up)
    y = jnp.einsum('becf,efd->becd', jax.nn.silu(a) * u, w_down)
    y = y * gates[..., None].astype(y.dtype)
    return jax.vmap(lambda ib, yb: jnp.zeros((S, D), yb.dtype).at[ib.reshape(-1)].add(yb.reshape(-1, D)))(idx, y)


def setup_inputs(seed: int = 0) -> dict:
    key = jax.random.key(seed)
    ks = jax.random.split(key, 24)
    f32 = jnp.float32
    D = D_MODEL

    def nrm(k, shape, fan_in):
        return jax.random.normal(k, shape, f32) * (fan_in ** -0.5)

    def gain(k, shape):
        return 1.0 + 0.02 * jax.random.normal(k, shape, f32)

    x = jax.random.normal(ks[0], (BATCH, SEQ, D), f32)
    c = jax.random.normal(ks[1], (BATCH, D), f32)
    offsets = jax.random.randint(ks[2], (BATCH, 1), 0, 1024, dtype=jnp.int32)
    positions = jnp.arange(SEQ, dtype=jnp.int32)[None, :] + offsets
    return {
        "x": x,
        "c": c,
        "positions": positions,
        "w_ada": 0.5 * nrm(ks[3], (DEPTH, D, 6 * D), D),
        "b_ada": 0.02 * jax.random.normal(ks[4], (DEPTH, 6 * D), f32),
        "norm1_g": gain(ks[5], (DEPTH, D)),
        "w_in": nrm(ks[6], (DEPTH, D, D_IN), D),
        "lb_logits": 0.5 * jax.random.normal(ks[7], (2, DEPTH + 1, HGRN_KWIDTH), f32),
        "hgrn_out_g": gain(ks[8], (DEPTH, HGRN_HEADS, HGRN_DV)),
        "qa_norm_g": gain(ks[9], (DEPTH, MLA_Q_LORA)),
        "w_uq": nrm(ks[10], (DEPTH, MLA_Q_LORA, MLA_HEADS * MLA_QK), MLA_Q_LORA),
        "kva_norm_g": gain(ks[11], (DEPTH, MLA_KV_LORA)),
        "w_ukv": nrm(ks[12], (DEPTH, MLA_KV_LORA, MLA_HEADS * (MLA_NOPE + MLA_V)), MLA_KV_LORA),
        "q_head_g": gain(ks[13], (DEPTH, MLA_QK)),
        "k_head_g": gain(ks[14], (DEPTH, MLA_QK)),
        "w_out": nrm(ks[15], (DEPTH, D_MIX, D), D_MIX),
        "norm2_g": gain(ks[16], (DEPTH, D)),
        "w_router": nrm(ks[17], (DEPTH, D, N_EXPERTS), D),
        "w_gate": nrm(ks[18], (DEPTH, N_EXPERTS, D, EXPERT_FF), D),
        "w_up": nrm(ks[19], (DEPTH, N_EXPERTS, D, EXPERT_FF), D),
        "w_down": nrm(ks[20], (DEPTH, N_EXPERTS, EXPERT_FF, D), EXPERT_FF),
    }


def reference(x, c, positions, w_ada, b_ada, norm1_g, w_in, lb_logits, hgrn_out_g, qa_norm_g, w_uq,
              kva_norm_g, w_ukv, q_head_g, k_head_g, w_out, norm2_g, w_router, w_gate, w_up, w_down):
    B, S, D = x.shape
    lb = jnp.cumsum(jax.nn.softmax(lb_logits.astype(jnp.float32), axis=1), axis=1)
    split_pts = _split_points()
    for l in range(DEPTH):
        mod = (jax.nn.silu(c) @ w_ada[l] + b_ada[l])[:, None, :]
        shift1, scale1, gate1, shift2, scale2, gate2 = jnp.split(mod, 6, axis=-1)

        h = rmsnorm(x, norm1_g[l]) * (1.0 + scale1) + shift1
        proj = h @ w_in[l]
        hq, hf_fwd, hf_bwd, hi, hg, cq, ckv, kpe = jnp.split(proj, split_pts, axis=-1)

        o_hgrn = hgrn2_bidirectional(hq, hi, hf_fwd, hf_bwd, lb[0, l], lb[1, l])
        o_hgrn = rmsnorm(o_hgrn, hgrn_out_g[l]).astype(x.dtype) * \
            jax.nn.silu(hg).reshape(B, S, HGRN_HEADS, HGRN_DV)
        o_hgrn = o_hgrn.reshape(B, S, HGRN_WIDTH)

        o_mla = mla_bidirectional(cq, ckv, kpe, positions, qa_norm_g[l], w_uq[l], kva_norm_g[l],
                                  w_ukv[l], q_head_g[l], k_head_g[l])

        mixed = jnp.concatenate([o_hgrn, o_mla], axis=-1)
        x = x + gate1 * (mixed @ w_out[l])

        h2 = rmsnorm(x, norm2_g[l]) * (1.0 + scale2) + shift2
        x = x + gate2 * expert_choice_ffn(h2, w_router[l], w_gate[l], w_up[l], w_down[l])
    return x
```

```cpp
#include <hip/hip_runtime.h>
#include <hip/hip_cooperative_groups.h>
#include <cstdio>
#include <cstdint>
namespace cg = cooperative_groups;

#ifndef MK_ONE_LAUNCH
#define MK_ONE_LAUNCH 1
#endif

#define DEVINL __device__ __forceinline__
#define LAS __attribute__((address_space(3)))
typedef unsigned short bf16_t;
typedef float f32x4 __attribute__((ext_vector_type(4)));
typedef unsigned u32x4 __attribute__((ext_vector_type(4)));
typedef unsigned u32x2 __attribute__((ext_vector_type(2)));
typedef short bf16x8 __attribute__((ext_vector_type(8)));

constexpr int NB = 4, SEQ = 2048, DM = 2048, NTOK = NB * SEQ;
constexpr int HH = 8, HDK = 128, HDV = 128, HW = 1024;
constexpr int MH = 8, QLORA = 512, KVLORA = 256, NOPE = 128, ROPE = 64, MV = 128, QK = 192;
constexpr int DIN = 5952, DINP = 6144;
constexpr int NE = 16, CAP = 256, FF = 2048, NSLOTROWS = NB * NE * CAP;
constexpr float EPS = 1e-6f;
constexpr int NWAVES = 8, NTHR = 512;
#ifndef HG_FUSED
#define HG_FUSED 1
#endif
#ifndef NS2
#define NS2 64
#endif
#ifndef CV_P0_END
#define CV_P0_END 13312
#endif
#ifndef CV_P2_END
#define CV_P2_END 32768
#endif
constexpr int CONV_E1 = 1024, CONV_M = 16 * CONV_E1, CONV_ALL = 3 * CONV_M;

constexpr size_t al256(size_t x) { return (x + 255) / 256 * 256; }
constexpr size_t WS_CTL = 0, CTL_BYTES = 1u << 20, CTL_ZERO_BYTES = 32768;
constexpr size_t WS_MOD = WS_CTL + CTL_BYTES;
constexpr size_t WS_LB = WS_MOD + al256((size_t)NB * 6 * DM * 4);
constexpr size_t WS_WIN = WS_LB + al256(2 * 1024 * 4);
constexpr size_t WS_WQ = WS_WIN + (size_t)DINP * DM * 2;
constexpr size_t WS_WKV = WS_WQ + (size_t)2048 * QLORA * 2;
constexpr size_t WS_WOUT = WS_WKV + (size_t)2048 * KVLORA * 2;
constexpr size_t WS_WG = WS_WOUT + (size_t)DM * DM * 2;
constexpr size_t WS_WU = WS_WG + (size_t)NE * FF * DM * 2;
constexpr size_t WS_WD = WS_WU + (size_t)NE * FF * DM * 2;
constexpr size_t WS_ACT = WS_WD + (size_t)NE * FF * DM * 2;
constexpr size_t WS_H = WS_ACT;
constexpr size_t WS_HQ = WS_H + (size_t)NTOK * DM * 2;
constexpr size_t WS_GF = WS_HQ + (size_t)NTOK * HW * 2;
constexpr size_t WS_GB = WS_GF + (size_t)NTOK * HW * 4;
constexpr size_t WS_HI = WS_GB + (size_t)NTOK * HW * 4;
constexpr size_t WS_HGS = WS_HI + (size_t)NTOK * HW * 2;
constexpr size_t WS_CQ = WS_HGS + (size_t)NTOK * HW * 2;
constexpr size_t WS_CKV = WS_CQ + (size_t)NTOK * QLORA * 2;
constexpr size_t WS_KPE = WS_CKV + (size_t)NTOK * KVLORA * 2;
constexpr size_t WS_QRAW = WS_KPE + (size_t)NTOK * ROPE * 4;
constexpr size_t WS_KVRAW = WS_QRAW + (size_t)NTOK * 2048 * 2;
constexpr size_t WS_QF = WS_KVRAW + (size_t)NTOK * 2048 * 2;
constexpr size_t WS_KF = WS_QF + (size_t)NB * MH * SEQ * QK * 2;
constexpr size_t WS_VF = WS_KF + (size_t)NB * MH * SEQ * QK * 2;
constexpr size_t WS_OF = WS_VF + (size_t)NB * MH * SEQ * MV * 2;
constexpr size_t WS_OB = WS_OF + (size_t)NTOK * HW * 4;
constexpr size_t WS_MIXED = WS_OB + (size_t)NTOK * HW * 4;
constexpr size_t WS_MIX_END = WS_MIXED + (size_t)NTOK * DM * 2;
constexpr size_t WS_H2 = WS_H;
constexpr size_t WS_XE = WS_HQ;
constexpr size_t WS_HMID = WS_XE + (size_t)NSLOTROWS * DM * 2;
constexpr size_t WS_Y = WS_HMID + (size_t)NSLOTROWS * FF * 2;
constexpr size_t WS_AFF = WS_Y + (size_t)NSLOTROWS * DM * 2;
constexpr size_t WS_GATE = WS_AFF + (size_t)NB * NE * SEQ * 4;
constexpr size_t WS_INV = WS_GATE + (size_t)NSLOTROWS * 4;
constexpr size_t WS_SEL = WS_INV + (size_t)NB * SEQ * NE * 2;
constexpr size_t WS_FFN_END = WS_SEL + (size_t)NSLOTROWS * 4;
constexpr size_t WS_X1 = al256(WS_MIX_END > WS_FFN_END ? WS_MIX_END : WS_FFN_END);
constexpr size_t WS_END = WS_X1 + (size_t)NTOK * DM * 4;
static_assert(WS_ACT % 256 == 0 && WS_END < (size_t)1020 * 1024 * 1024, "d_ws map");

constexpr int LDS_BYTES = 147456;

DEVINL float bf2f(unsigned b) { return __uint_as_float(b << 16); }
DEVINL unsigned f2bf(float f) { unsigned u = __float_as_uint(f); return (u + 0x7fffu + ((u >> 16) & 1u)) >> 16; }
typedef float f32x2_t __attribute__((ext_vector_type(2))); typedef __bf16 bf16x2_t __attribute__((ext_vector_type(2)));
DEVINL unsigned pk2(float lo, float hi) { f32x2_t v = {lo, hi}; bf16x2_t b = __builtin_convertvector(v, bf16x2_t); return __builtin_bit_cast(unsigned, b); }
DEVINL float wave_sum(float v) {
#pragma unroll
    for (int o = 1; o < 64; o <<= 1) v += __shfl_xor(v, o);
    return v;
}
DEVINL float sigmoidf_(float z) { return __builtin_amdgcn_rcpf(1.f + __builtin_amdgcn_exp2f(-1.4426950408889634f * z)); }
#define LDS_WAIT() asm volatile("s_waitcnt lgkmcnt(0)" ::: "memory")

DEVINL const void* ldptr(const LAS unsigned long long* st, int i) { const unsigned long long v = st[i]; const unsigned lo = __builtin_amdgcn_readfirstlane((unsigned)v), hi = __builtin_amdgcn_readfirstlane((unsigned)(v >> 32)); return (const void*)(((unsigned long long)hi << 32) | lo); }
struct Params {
    const float *x, *c; const int* pos;
    const float *w_ada, *b_ada, *norm1_g, *w_in, *lb_logits, *hgrn_out_g, *qa_norm_g, *w_uq, *kva_norm_g, *w_ukv, *q_head_g, *k_head_g, *w_out, *norm2_g, *w_router, *w_gate, *w_up, *w_down;
    float* out; unsigned char* ws; int ph_lo, ph_hi;
};

#define XB_TMO      128
#define XB_XCNT(j)  (256  + 64 * (j))
#define XB_XSUB(j)  (1280 + 64 * (j))
#define XB_XGEN(j)  (2304 + 64 * (j))
#define XB_TOP      3328
#define XB_TOPGEN   3392
#define XCD_BAR_WORDS 3456
#define XB_SPIN_CAP (1u << 18)
constexpr int CW_MODCNT = 64, CW_HGQ = 96, CW_SQ2 = 2240, CW_SQ5 = 2304, CW_HGCNT = 128;
constexpr int CW_BAR = 4096;
constexpr int MISC_OFF = 131072;
DEVINL unsigned xb_ld(unsigned* p)              { return __hip_atomic_load(p, __ATOMIC_RELAXED, __HIP_MEMORY_SCOPE_AGENT); }
DEVINL unsigned xb_add(unsigned* p, unsigned v) { return __hip_atomic_fetch_add(p, v, __ATOMIC_RELAXED, __HIP_MEMORY_SCOPE_AGENT); }
DEVINL unsigned xb_xcc_id() { return (unsigned)__builtin_amdgcn_s_getreg((3 << 11) | 20) & 0xFu; }
#define XB_SPIN(cond, bar) do { unsigned _sp = 0; while (cond) { __builtin_amdgcn_s_sleep(1); \
    if ((++_sp & 255u) == 0u) { if (xb_ld(&(bar)[XB_TMO])) break; if (_sp > XB_SPIN_CAP) { atomicAdd(&(bar)[XB_TMO], 1u); break; } } } } while (0)
struct XcdBarrier { unsigned* bar; unsigned x; volatile LAS unsigned* st; };
DEVINL XcdBarrier xcd_barrier_post(unsigned* bar, volatile LAS unsigned* st) {
    XcdBarrier b; b.bar = bar; b.x = xb_xcc_id(); b.st = st;
    if (threadIdx.x == 0) (void)xb_add(&bar[XB_XCNT(b.x)], 1u);
    return b;
}
DEVINL void xcd_barrier_complete(unsigned* bar, unsigned x, unsigned& nloc, unsigned& nx) {
    const unsigned G = gridDim.x * gridDim.y * gridDim.z;
    unsigned sum, cnt, mine, sp = 0u;
    for (;;) {
        sum = 0u; cnt = 0u; mine = 0u;
#pragma unroll
        for (unsigned j = 0; j < 16; ++j) { const unsigned c = xb_ld(&bar[XB_XCNT(j)]); sum += c; cnt += (c > 0u) ? 1u : 0u; mine = (j == x) ? c : mine; }
        if (sum == G) break;
        __builtin_amdgcn_s_sleep(1);
        if ((++sp & 255u) == 0u) { if (xb_ld(&bar[XB_TMO])) break; if (sp > XB_SPIN_CAP) { atomicAdd(&bar[XB_TMO], 1u); break; } }
    }
    nloc = mine > 0u ? mine : 1u; nx = cnt > 0u ? cnt : 1u;
}
DEVINL void xcd_barrier(const XcdBarrier& b) {
    asm volatile("s_waitcnt vmcnt(0)" ::: "memory");
    __syncthreads();
    if (threadIdx.x == 0) {
        unsigned* bar = b.bar;
        __builtin_amdgcn_s_waitcnt(0);
        unsigned nloc = b.st[0], nx = b.st[1];
        if (nloc == 0u) { xcd_barrier_complete(bar, b.x, nloc, nx); b.st[0] = nloc; b.st[1] = nx; }
        const unsigned old = xb_add(&bar[XB_XSUB(b.x)], 1u);
        const unsigned gen = old / nloc;
        if (old + 1u == (gen + 1u) * nloc) {
            __builtin_amdgcn_fence(__ATOMIC_RELEASE, "agent");
            asm volatile("s_waitcnt vmcnt(0)" ::: "memory");
            const unsigned og = xb_add(&bar[XB_TOP], 1u);
            const unsigned tg = og / nx;
            if (og + 1u == (tg + 1u) * nx) xb_add(&bar[XB_TOPGEN], 1u);
            else XB_SPIN(xb_ld(&bar[XB_TOPGEN]) == tg, bar);
            __builtin_amdgcn_fence(__ATOMIC_ACQUIRE, "agent");
            xb_add(&bar[XB_XGEN(b.x)], 1u);
            asm volatile("s_waitcnt vmcnt(0)" ::: "memory");
        } else {
            XB_SPIN(xb_ld(&bar[XB_XGEN(b.x)]) == gen, bar);
            __builtin_amdgcn_fence(__ATOMIC_ACQUIRE, "agent");
            asm volatile("s_waitcnt vmcnt(0)" ::: "memory");
        }
    }
    __syncthreads();
}

DEVINL void p0_transpose_item(const float* W, int ldn, int K, int Ncols, bf16_t* WT, const float* kscale, LAS float* scr, int item, int lane) {
    const int nblk = Ncols / 32, kb = item / nblk, nb = item % nblk, k0 = 64 * kb, n0 = 32 * nb;
#pragma unroll 8
    for (int i = 0; i < 32; ++i) { const int kk = 2 * i + (lane >> 5); float v = W[(size_t)(k0 + kk) * ldn + n0 + (lane & 31)]; if (kscale) v *= kscale[k0 + kk]; scr[kk * 33 + (lane & 31)] = v; }
    LDS_WAIT();
    const int c = lane & 7;
#pragma unroll
    for (int j = 0; j < 4; ++j) { const int n = (lane >> 3) + 8 * j; const LAS float* s = scr + (8 * c) * 33 + n;
        u32x4 o; o.x = pk2(s[0 * 33], s[1 * 33]); o.y = pk2(s[2 * 33], s[3 * 33]); o.z = pk2(s[4 * 33], s[5 * 33]); o.w = pk2(s[6 * 33], s[7 * 33]);
        *(u32x4*)(WT + (size_t)(n0 + n) * K + k0 + 8 * c) = o; }
    LDS_WAIT();
}

#define P0_X(r) ((((r) >> 1) & 1) | ((((r) >> 3) & 1) << 1))
DEVINL void t64_load(const float* src, int ldn, f32x4 (&v)[16], int lane) {
    const float* s0 = src + (size_t)(lane >> 4) * ldn + 4 * (lane & 15);
#pragma unroll
    for (int i = 0; i < 16; ++i) v[i] = *(const f32x4*)(s0 + (size_t)(4 * i) * ldn);
}
DEVINL void t64_process(const f32x4 (&v)[16], bf16_t* dst, int K, LAS unsigned char* scr, int lane) {
    const int g = lane >> 4, i16 = lane & 15;
#pragma unroll
    for (int i = 0; i < 16; ++i) { const int k = 4 * i + g; u32x2 w; w.x = pk2(v[i].x, v[i].y); w.y = pk2(v[i].z, v[i].w);
        *(LAS u32x2*)(scr + k * 128 + ((8 * i16) ^ (P0_X(k) << 5))) = w; }
    LDS_WAIT();
    const int q = i16 >> 2, pp = i16 & 3; const bool lo8 = i16 < 8;
#pragma unroll
    for (int j = 0; j < 4; ++j) {
        u32x4 A[2];
#pragma unroll
        for (int kk = 0; kk < 2; ++kk) { const int r0 = 32 * kk + 8 * g + q, r1 = r0 + 4;
            const int a0 = (int)(uintptr_t)scr + r0 * 128 + ((32 * j + 8 * pp) ^ (P0_X(r0) << 5)), a1 = (int)(uintptr_t)scr + r1 * 128 + ((32 * j + 8 * pp) ^ (P0_X(r1) << 5));
            u32x2 lo, hi; asm volatile("ds_read_b64_tr_b16 %0, %1" : "=v"(lo) : "v"(a0) : "memory"); asm volatile("ds_read_b64_tr_b16 %0, %1" : "=v"(hi) : "v"(a1) : "memory");
            asm volatile("s_waitcnt lgkmcnt(0)" : "+v"(lo), "+v"(hi) :: "memory");
            A[kk] = (u32x4){lo.x, lo.y, hi.x, hi.y}; }
        const u32x4 snd = lo8 ? A[1] : A[0]; u32x4 rcv;
        rcv.x = __shfl_xor(snd.x, 8); rcv.y = __shfl_xor(snd.y, 8); rcv.z = __shfl_xor(snd.z, 8); rcv.w = __shfl_xor(snd.w, 8);
        const int kc = lo8 ? 8 * g : 32 + 8 * g;
        *(u32x4*)(dst + (size_t)(16 * j + (i16 & 7)) * K + kc) = lo8 ? A[0] : rcv;
        *(u32x4*)(dst + (size_t)(16 * j + 8 + (i16 & 7)) * K + kc) = lo8 ? rcv : A[1]; }
    LDS_WAIT();
}
DEVINL void p0_transpose_tile64(const float* W, int ldn, int K, int Ncols, bf16_t* WT, LAS unsigned char* scr, int item, int lane) {
    const int nblk = Ncols / 64, kb = item / nblk, nb = item % nblk, k0 = 64 * kb, n0 = 64 * nb;
    f32x4 v[16]; t64_load(W + (size_t)k0 * ldn + n0, ldn, v, lane); t64_process(v, WT + (size_t)n0 * K + k0, K, scr, lane);
}
DEVINL void conv_ptrs(const Params& p, int id, const float*& src, bf16_t*& dst) {
    const int m = id / CONV_M, r = id % CONV_M, e = r / CONV_E1, t = r % CONV_E1, kb = t >> 5, nb = t & 31; const size_t eo = (size_t)e * DM * FF;
    const float* W = m == 0 ? p.w_gate : (m == 1 ? p.w_up : p.w_down); bf16_t* WT = (bf16_t*)(p.ws + (m == 0 ? WS_WG : (m == 1 ? WS_WU : WS_WD)));
    src = W + eo + (size_t)(64 * kb) * 2048 + 64 * nb; dst = WT + eo + (size_t)(64 * nb) * 2048 + 64 * kb;
}
DEVINL void conv_stream(const Params& p, LAS unsigned char* scr, int first, int stride, int end, int lane) {
    if (first >= end) return;
    f32x4 va[16], vb[16]; const float* sa; bf16_t* da; const float* sb; bf16_t* db;
    int it0 = first; conv_ptrs(p, it0, sa, da); t64_load(sa, 2048, va, lane);
    for (;;) {
        const int it1 = it0 + stride; if (it1 < end) { conv_ptrs(p, it1, sb, db); t64_load(sb, 2048, vb, lane); }
        t64_process(va, da, 2048, scr, lane); if (it1 >= end) break;
        it0 = it1 + stride; if (it0 < end) { conv_ptrs(p, it0, sa, da); t64_load(sa, 2048, va, lane); }
        t64_process(vb, db, 2048, scr, lane); if (it0 >= end) break;
    }
}
DEVINL int conv_pop(unsigned* q) { unsigned v = 0; if ((threadIdx.x & 63) == 0) v = __hip_atomic_fetch_add(q, 1u, __ATOMIC_RELAXED, __HIP_MEMORY_SCOPE_AGENT); return (int)__builtin_amdgcn_readfirstlane(v); }
DEVINL void conv_stream_q(const Params& p, LAS unsigned char* scr, unsigned* q, int begin, int end, int lane) {
    f32x4 va[16], vb[16]; const float* sa; bf16_t* da; const float* sb; bf16_t* db;
    int it0 = begin + 2 * conv_pop(q); if (it0 >= end) return;
    conv_ptrs(p, it0, sa, da); t64_load(sa, 2048, va, lane);
    for (;;) {
        const int it1 = it0 + 1; if (it1 < end) { conv_ptrs(p, it1, sb, db); t64_load(sb, 2048, vb, lane); }
        t64_process(va, da, 2048, scr, lane); if (it1 >= end) break;
        it0 = begin + 2 * conv_pop(q); if (it0 < end) { conv_ptrs(p, it0, sa, da); t64_load(sa, 2048, va, lane); }
        t64_process(vb, db, 2048, scr, lane); if (it0 >= end) break;
    }
}
DEVINL void p0_gemv_item(const Params& p, LAS unsigned char* lds, int it, int tid, int wave, int lane) {
    LAS float* sc = (LAS float*)lds;
    LAS float* red = (LAS float*)(lds + 32768);
    for (int i = tid; i < NB * DM; i += NTHR) { const float v = p.c[i]; sc[i] = v / (1.f + __expf(-v)); }
    __syncthreads();
    const int cq = lane & 15, ks = lane >> 4;
    f32x4 acc[4]; for (int b = 0; b < 4; ++b) acc[b] = (f32x4){0.f, 0.f, 0.f, 0.f};
    const float* wp = p.w_ada + (size_t)(256 * wave + ks) * (6 * DM) + 48 * it + 4 * (cq < 12 ? cq : 0);
#pragma unroll 8
    for (int i = 0; i < 64; ++i) { const f32x4 w = *(const f32x4*)(wp + (size_t)(4 * i) * (6 * DM)); const int k = 256 * wave + 4 * i + ks;
#pragma unroll
        for (int b = 0; b < 4; ++b) acc[b] += w * sc[b * DM + k]; }
#pragma unroll
    for (int b = 0; b < 4; ++b)
#pragma unroll
        for (int j = 0; j < 4; ++j) { float v = acc[b][j]; v += __shfl_xor(v, 16); v += __shfl_xor(v, 32); acc[b][j] = v; }
    if (ks == 0 && cq < 12) {
#pragma unroll
        for (int b = 0; b < 4; ++b)
#pragma unroll
            for (int j = 0; j < 4; ++j) red[(wave * 4 + b) * 64 + 4 * cq + j] = acc[b][j]; }
    __syncthreads();
    if (tid < 256 && (tid & 63) < 48) { const int b = tid >> 6, col = tid & 63; float s = p.b_ada[48 * it + col];
#pragma unroll
        for (int w = 0; w < 8; ++w) s += red[(w * 4 + b) * 64 + col];
        ((float*)(p.ws + WS_MOD))[b * 6 * DM + 48 * it + col] = s; }
    asm volatile("s_waitcnt vmcnt(0)" ::: "memory");
    __syncthreads();
    if (tid == 0) { __builtin_amdgcn_fence(__ATOMIC_RELEASE, "agent"); asm volatile("s_waitcnt vmcnt(0)" ::: "memory"); __hip_atomic_fetch_add((unsigned*)(p.ws + WS_CTL) + CW_MODCNT, 1u, __ATOMIC_RELAXED, __HIP_MEMORY_SCOPE_AGENT); }
}

DEVINL void phase0(const Params& p, LAS unsigned char* lds, int tid, int wave, int lane) {
    const int G = gridDim.x;
    for (int it = blockIdx.x; it < 6 * DM / 48; it += G) p0_gemv_item(p, lds, it, tid, wave, lane);
    __syncthreads();
    LAS float* scr = (LAS float*)(lds + wave * 16384);
    const int gw = blockIdx.x * NWAVES + wave, NGW = G * NWAVES;
    constexpr int I_IN = (DM / 64) * (DIN / 64), I_Q1 = (QLORA / 64) * (QK / 32), I_Q = MH * I_Q1, I_KV = (KVLORA / 64) * (2048 / 32), I_OUT = (DM / 64) * (DM / 64), I_E1 = (DM / 64) * (FF / 64), I_E = NE * I_E1;
    constexpr int NITEMS = I_IN + I_Q + I_KV + I_OUT;
    bf16_t* Win_t = (bf16_t*)(p.ws + WS_WIN); bf16_t* Wq_t = (bf16_t*)(p.ws + WS_WQ); bf16_t* Wkv_t = (bf16_t*)(p.ws + WS_WKV); bf16_t* Wout_t = (bf16_t*)(p.ws + WS_WOUT);
    bf16_t* Wg_t = (bf16_t*)(p.ws + WS_WG); bf16_t* Wu_t = (bf16_t*)(p.ws + WS_WU); bf16_t* Wd_t = (bf16_t*)(p.ws + WS_WD);
    for (int it = gw; it < NITEMS; it += NGW) {
        int r = it;
        if (r < I_IN) { p0_transpose_tile64(p.w_in, DIN, DM, DIN, Win_t, (LAS unsigned char*)scr, r, lane); continue; } r -= I_IN;
        if (r < I_Q) { const int h = r / I_Q1; p0_transpose_item(p.w_uq + h * QK, MH * QK, QLORA, QK, Wq_t + (size_t)h * 256 * QLORA, p.qa_norm_g, scr, r % I_Q1, lane); continue; } r -= I_Q;
        if (r < I_KV) { p0_transpose_item(p.w_ukv, 2048, KVLORA, 2048, Wkv_t, p.kva_norm_g, scr, r, lane); continue; } r -= I_KV;
        if (r < I_OUT) { p0_transpose_tile64(p.w_out, DM, DM, DM, Wout_t, (LAS unsigned char*)scr, r, lane); continue; } r -= I_OUT;
    }
    conv_stream(p, (LAS unsigned char*)scr, gw, NGW, CV_P0_END, lane);
    const size_t gt = (size_t)blockIdx.x * NTHR + tid, GT = (size_t)G * NTHR;
    const u32x4 z = {0u, 0u, 0u, 0u};
    for (size_t i = gt; i < (size_t)(DINP - DIN) * DM / 8; i += GT) *(u32x4*)(Win_t + (size_t)DIN * DM + i * 8) = z;
    for (size_t i = gt; i < (size_t)MH * 64 * QLORA / 8; i += GT) { const size_t h = i / (64 * QLORA / 8), o = i % (64 * QLORA / 8); *(u32x4*)(Wq_t + (h * 256 + QK) * QLORA + o * 8) = z; }
    for (size_t i = gt; i < 2 * 1024; i += GT) { const int dir = (int)(i >> 10), k = (int)(i & 1023); const float l0 = p.lb_logits[dir * 2048 + k], l1 = p.lb_logits[dir * 2048 + 1024 + k];
        ((float*)(p.ws + WS_LB))[i] = 1.f / (1.f + __expf(l1 - l0)); }
}

DEVINL void stream_items(const Params& p, LAS unsigned char* lds, int qword, int begin, int end, int sidx, int nstream, int wave, int lane) {
    LAS unsigned char* scr = lds + wave * 16384;
    (void)sidx; (void)nstream; conv_stream_q(p, scr, (unsigned*)(p.ws + WS_CTL) + qword, begin, end, lane);
}

DEVINL void phase1(const Params& p, int wave, int lane) {
    const int gw = blockIdx.x * NWAVES + wave, NGW = gridDim.x * NWAVES;
    const float* MOD = (const float*)(p.ws + WS_MOD); bf16_t* H = (bf16_t*)(p.ws + WS_H);
    for (int row = gw; row < NTOK; row += NGW) {
        const int b = row >> 11; const f32x4* xr = (const f32x4*)(p.x + (size_t)row * DM) + lane;
        f32x4 v[8]; float s = 0.f;
#pragma unroll
        for (int j = 0; j < 8; ++j) { v[j] = xr[64 * j]; s += (v[j].x * v[j].x + v[j].y * v[j].y) + (v[j].z * v[j].z + v[j].w * v[j].w); }
        const float r = 1.f / sqrtf(wave_sum(s) * (1.f / DM) + EPS);
        u32x2* o = (u32x2*)(H + (size_t)row * DM) + lane;
#pragma unroll
        for (int j = 0; j < 8; ++j) { const int col = 4 * (lane + 64 * j);
            const f32x4 g = *(const f32x4*)(p.norm1_g + col), sh = *(const f32x4*)(MOD + b * 6 * DM + col), sc = *(const f32x4*)(MOD + b * 6 * DM + DM + col);
            const f32x4 h = v[j] * r * g * (sc + 1.f) + sh; u32x2 w; w.x = pk2(h.x, h.y); w.y = pk2(h.z, h.w); o[64 * j] = w; }
    }
}

DEVINL void st_bf16x8(bf16_t* dst, const float (&v)[8]) { u32x4 w; w.x = pk2(v[0], v[1]); w.y = pk2(v[2], v[3]); w.z = pk2(v[4], v[5]); w.w = pk2(v[6], v[7]); *(u32x4*)dst = w; }
struct EpiProj {
    unsigned char* ws;
    DEVINL void store(int row, int col, const float (&v)[8]) const {
        if (col < 1024) { st_bf16x8((bf16_t*)(ws + WS_HQ) + (size_t)row * HW + col, v); }
        else if (col < 3072) { const int dir = (col - 1024) >> 10, k = (col - 1024) & 1023; const float* lb = (const float*)(ws + WS_LB) + dir * 1024 + k; float* G = (float*)(ws + (dir ? WS_GB : WS_GF)) + (size_t)row * HW + k;
            float g[8];
#pragma unroll
            for (int j = 0; j < 8; ++j) { const float l = lb[j]; g[j] = __builtin_amdgcn_logf(l + (1.f - l) * sigmoidf_(v[j])); }
            *(f32x4*)G = (f32x4){g[0], g[1], g[2], g[3]}; *(f32x4*)(G + 4) = (f32x4){g[4], g[5], g[6], g[7]}; }
        else if (col < 4096) { st_bf16x8((bf16_t*)(ws + WS_HI) + (size_t)row * HW + (col - 3072), v); }
        else if (col < 5120) { float s[8];
#pragma unroll
            for (int j = 0; j < 8; ++j) s[j] = v[j] * sigmoidf_(v[j]);
            st_bf16x8((bf16_t*)(ws + WS_HGS) + (size_t)row * HW + (col - 4096), s); }
        else if (col < 5632) { st_bf16x8((bf16_t*)(ws + WS_CQ) + (size_t)row * QLORA + (col - 5120), v); }
        else if (col < 5888) { st_bf16x8((bf16_t*)(ws + WS_CKV) + (size_t)row * KVLORA + (col - 5632), v); }
        else if (col < 5952) { float* K = (float*)(ws + WS_KPE) + (size_t)row * ROPE + (col - 5888); *(f32x4*)K = (f32x4){v[0], v[1], v[2], v[3]}; *(f32x4*)(K + 4) = (f32x4){v[4], v[5], v[6], v[7]}; }
    }
};
struct EpiBf16 { bf16_t* O; int ldo; DEVINL void store(int row, int col, const float (&v)[8]) const { st_bf16x8(O + (size_t)row * ldo + col, v); } };
struct EpiOut {
    const float* x; const float* MOD; float* out;
    DEVINL void store(int row, int col, const float (&v)[8]) const { const int b = row >> 11; const float* g = MOD + b * 6 * DM + 2 * DM + col; const float* xr = x + (size_t)row * DM + col; float* o = out + (size_t)row * DM + col;
        const f32x4 g0 = *(const f32x4*)g, g1 = *(const f32x4*)(g + 4), x0 = *(const f32x4*)xr, x1 = *(const f32x4*)(xr + 4);
        *(f32x4*)o = x0 + g0 * (f32x4){v[0], v[1], v[2], v[3]}; *(f32x4*)(o + 4) = x1 + g1 * (f32x4){v[4], v[5], v[6], v[7]}; }
};
struct EpiSwiglu {
    bf16_t* O;
    DEVINL void store2(int row, int col, const float (&a)[8], const float (&u)[8]) const { float h[8];
#pragma unroll
        for (int j = 0; j < 8; ++j) h[j] = a[j] * sigmoidf_(a[j]) * u[j];
        st_bf16x8(O + (size_t)row * FF + col, h); }
};
struct EpiDown {
    bf16_t* Y; const float* gate;
    DEVINL void store(int row, int col, const float (&v)[8]) const { const float g = gate[row]; float y[8];
#pragma unroll
        for (int j = 0; j < 8; ++j) y[j] = v[j] * g;
        st_bf16x8(Y + (size_t)row * DM + col, y); }
};

DEVINL void ld8f(const bf16_t* p, float (&f)[8]) { const u32x4 w = *(const u32x4*)p; f[0] = bf2f(w.x & 0xffffu); f[1] = bf2f(w.x >> 16); f[2] = bf2f(w.y & 0xffffu); f[3] = bf2f(w.y >> 16); f[4] = bf2f(w.z & 0xffffu); f[5] = bf2f(w.z >> 16); f[6] = bf2f(w.w & 0xffffu); f[7] = bf2f(w.w >> 16); }
template <bool DUAL, class Epi>
DEVINL void naive_gemm(const bf16_t* A, int lda, const bf16_t* Bt, const bf16_t* Bt2, int ldb, size_t estride  , int M, int N, int K, const Epi& E, int wave, int lane) {
    constexpr int RT = DUAL ? 2 : 4;
    const int gw = blockIdx.x * NWAVES + wave, NGW = gridDim.x * NWAVES, ntn = N / 64, ntiles = (M / (8 * RT)) * ntn;
    const int lr = lane >> 3, lc = lane & 7;
    for (int t = gw; t < ntiles; t += NGW) {
        const int r0 = (t / ntn) * (8 * RT) + lr * RT, c0 = (t % ntn) * 64 + lc * 8;
        const size_t eo = estride ? (size_t)(r0 >> 10) * estride : 0;
        const bf16_t* ap = A + (size_t)r0 * lda; const bf16_t* bp = Bt + eo + (size_t)c0 * ldb; const bf16_t* bp2 = DUAL ? Bt2 + eo + (size_t)c0 * ldb : nullptr;
        float acc[RT][8], acc2[RT][8];
#pragma unroll
        for (int i = 0; i < RT; ++i)
#pragma unroll
            for (int j = 0; j < 8; ++j) { acc[i][j] = 0.f; acc2[i][j] = 0.f; }
        for (int k = 0; k < K; k += 8) {
            float a[RT][8];
#pragma unroll
            for (int i = 0; i < RT; ++i) ld8f(ap + (size_t)i * lda + k, a[i]);
#pragma unroll
            for (int j = 0; j < 8; ++j) { float b[8]; ld8f(bp + (size_t)j * ldb + k, b);
#pragma unroll
                for (int i = 0; i < RT; ++i)
#pragma unroll
                    for (int q = 0; q < 8; ++q) acc[i][j] += a[i][q] * b[q];
                if (DUAL) { ld8f(bp2 + (size_t)j * ldb + k, b);
#pragma unroll
                    for (int i = 0; i < RT; ++i)
#pragma unroll
                        for (int q = 0; q < 8; ++q) acc2[i][j] += a[i][q] * b[q]; } }
        }
#pragma unroll
        for (int i = 0; i < RT; ++i) { if constexpr (DUAL) E.store2(r0 + i, c0, acc[i], acc2[i]); else E.store(r0 + i, c0, acc[i]); }
    }
}

namespace g8 {
constexpr int BM = 256, BK = 64, HALF = 128, HTB = HALF * BK * 2  , STAGE_BYTES = 8 * HTB;
__host__ __device__ __forceinline__ int lds_byte(int r, int c) { const int st = (r >> 4) * 2 + (c >> 5), rr = r & 15, cc = c & 31, ob = rr * 64 + cc * 2; return st * 1024 + (ob ^ (((ob >> 9) & 1) << 5)); }
__host__ __device__ __forceinline__ void stage_rc(int b, int& R, int& C) { const int st = b / 1024, sb = b % 1024, swz = sb ^ (((sb >> 9) & 1) << 5); R = (st >> 1) * 16 + swz / 64; C = (st & 1) * 32 + (swz % 64) / 2; }
__host__ __device__ __forceinline__ int perm32(int rho) { const int n = rho >> 4, i = rho & 15; return 8 * (i >> 2) + 4 * n + (i & 3); }
struct Unit { const char *a0, *a1, *b0, *b1; const int* sel; int row0, col0; };
struct TileOrder { int nM, nN, nwg, G, c, dup;
    DEVINL void init(int nM_, int nN_, int G_, int c_, int dup_ = 0) { nM = nM_; nN = nN_; nwg = nM * nN; G = G_; c = c_; dup = dup_; }
    DEVINL bool tile(int i, int& pm, int& pn) const {
        const long L = (long)(i >> dup) * G + c; if (L >= nwg) return false;
        int wgid = (int)L; { const int q = nwg / 8, r = nwg % 8, xcd = wgid % 8, off = wgid / 8; wgid = (xcd < r ? xcd * (q + 1) : r * (q + 1) + (xcd - r) * q) + off; }
        const int nig = 8 * nN, gid = wgid / nig, fm = gid * 8, gsz = (nM - fm) < 8 ? (nM - fm) : 8;
        pm = fm + ((wgid % nig) % gsz); pn = (wgid % nig) / gsz; return true; } };
template <bool DUAL, class Epi, class Sched, bool GATHER = false, bool SP2 = true, bool ALIGN_EPI = true>
DEVINL void gemm_phase(LAS unsigned char* lds, const int K, const int lda, const int ldb, const Sched& S, const Epi& E) {
    const int tid = threadIdx.x, wid = __builtin_amdgcn_readfirstlane(tid >> 6), lane = tid & 63, wr = wid >> 2, wc = wid & 3, fr = lane & 15, fq = lane >> 4;
    const int nt = K / BK;
    unsigned voffA[2], voffB[2]; int rA[2];
#pragma unroll
    for (int i = 0; i < 2; ++i) { int R, C; stage_rc(tid * 16 + i * 8192, R, C); const int Rb = (R & ~31) + perm32(R & 31); rA[i] = R;
        voffA[i] = GATHER ? (unsigned)C * 2u : (unsigned)(R * lda + C) * 2u; voffB[i] = (unsigned)(Rb * ldb + C) * 2u; }
    unsigned vA0[2], vA1[2]; int nt0[2] = {0, 0}, nt1[2] = {0, 0};
    const size_t kstep = (size_t)(BK * 2);
    const unsigned ldsw = (unsigned)wid * 1024u;
    const int aoff = lds_byte(wr * 64 + fr, fq * 8), boff = lds_byte(wc * 32 + fr, fq * 8);
#define G8_SA(b, h) (((b) * 2 + (h)) * HTB)
#define G8_SB(b, h) ((4 + (b) * 2 + (h)) * HTB)
#define G8_STAGE(bufoff, gbase, voff) do { _Pragma("unroll") for (int _i = 0; _i < 2; ++_i) \
        __builtin_amdgcn_global_load_lds((const unsigned*)((const char*)(gbase) + (voff)[_i]), (LAS unsigned*)(lds + (bufoff) + ldsw + _i * 8192), 16, 0, 0); } while (0)
#define G8_STAGE2(bufoff, gbase, v0_, v1_) do { \
        __builtin_amdgcn_global_load_lds((const unsigned*)((const char*)(gbase) + (v0_)), (LAS unsigned*)(lds + (bufoff) + ldsw), 16, 0, 0); \
        __builtin_amdgcn_global_load_lds((const unsigned*)((const char*)(gbase) + (v1_)), (LAS unsigned*)(lds + (bufoff) + ldsw + 8192), 16, 0, 0); } while (0)
#define G8_LDA(dst, b, h) do { _Pragma("unroll") for (int m = 0; m < 4; ++m) _Pragma("unroll") for (int k = 0; k < 2; ++k) dst[m][k] = *(const LAS bf16x8*)(lds + G8_SA(b, h) + aoff + m * 2048 + k * 1024); } while (0)
#define G8_LDB(dst, b, h) do { _Pragma("unroll") for (int n = 0; n < 2; ++n) _Pragma("unroll") for (int k = 0; k < 2; ++k) dst[n][k] = *(const LAS bf16x8*)(lds + G8_SB(b, h) + boff + n * 2048 + k * 1024); } while (0)
#define G8_MMA(ai, bj, At, Bt) do { __builtin_amdgcn_s_setprio(1); _Pragma("unroll") for (int m = 0; m < 4; ++m) _Pragma("unroll") for (int n = 0; n < 2; ++n) _Pragma("unroll") for (int k = 0; k < 2; ++k) \
        acc[ai][bj][m][n] = __builtin_amdgcn_mfma_f32_16x16x32_bf16(Bt[n][k], At[m][k], acc[ai][bj][m][n], 0, 0, 0); __builtin_amdgcn_s_setprio(0); } while (0)
#define G8_WAIT_V(n) asm volatile("s_waitcnt vmcnt(" #n ")" ::: "memory")
#define G8_WAIT_L(n) asm volatile("s_waitcnt lgkmcnt(" #n ")" ::: "memory")
#define G8_BAR __builtin_amdgcn_s_barrier()
#define G8_SCHED __builtin_amdgcn_sched_barrier(0)
    Unit cur, nxt; int ui = 0;
    if (!S.next(0, cur)) return;
    f32x4 acc[2][2][4][2];
#pragma unroll
    for (int a = 0; a < 2; ++a)
#pragma unroll
        for (int b = 0; b < 2; ++b)
#pragma unroll
            for (int m = 0; m < 4; ++m)
#pragma unroll
                for (int n = 0; n < 2; ++n) acc[a][b][m][n] = (f32x4){0.f, 0.f, 0.f, 0.f};
    bf16x8 At[4][2], B0[2][2], B1[2][2];
    const char *cA0 = cur.a0, *cA1 = cur.a1, *cB0 = cur.b0, *cB1 = cur.b1;
    if constexpr (GATHER) {
#pragma unroll
        for (int i = 0; i < 2; ++i) { vA0[i] = (unsigned)cur.sel[rA[i]] * (unsigned)(lda * 2) + voffA[i]; vA1[i] = (unsigned)cur.sel[128 + rA[i]] * (unsigned)(lda * 2) + voffA[i]; } }
    else { vA0[0] = vA1[0] = voffA[0]; vA0[1] = vA1[1] = voffA[1]; }
    if constexpr (SP2) {
        G8_STAGE(G8_SB(0, 0), cB0, voffB); G8_STAGE(G8_SB(0, 1), cB1, voffB); G8_STAGE2(G8_SA(0, 0), cA0, vA0[0], vA0[1]); G8_STAGE2(G8_SA(0, 1), cA1, vA1[0], vA1[1]);
        if (wr == 1) G8_BAR;
        G8_WAIT_V(2); G8_BAR;
        G8_STAGE(G8_SB(1, 0), cB0 + kstep, voffB); G8_STAGE2(G8_SA(1, 0), cA0 + kstep, vA0[0], vA0[1]); G8_STAGE(G8_SB(1, 1), cB1 + kstep, voffB);
        G8_WAIT_V(6); G8_BAR;
    } else {
        G8_STAGE(G8_SB(0, 0), cB0, voffB); G8_STAGE(G8_SA(0, 0), cA0, voffA); G8_STAGE(G8_SB(0, 1), cB1, voffB); G8_STAGE(G8_SA(0, 1), cA1, voffA);
        if (wr == 1) G8_BAR;
        G8_WAIT_V(4); G8_BAR;
        G8_STAGE(G8_SB(1, 0), cB0 + kstep, voffB); G8_STAGE(G8_SA(1, 0), cA0 + kstep, voffA); G8_STAGE(G8_SB(1, 1), cB1 + kstep, voffB);
        G8_WAIT_V(6); G8_BAR;
    }
    for (;;) {
        const bool has_next = S.next(ui + 1, nxt);
        const char *nA0 = has_next ? nxt.a0 : cA0, *nA1 = has_next ? nxt.a1 : cA1, *nB0 = has_next ? nxt.b0 : cB0, *nB1 = has_next ? nxt.b1 : cB1;
        if constexpr (GATHER) { if (has_next) {
#pragma unroll
            for (int i = 0; i < 2; ++i) { nt0[i] = nxt.sel[rA[i]]; nt1[i] = nxt.sel[128 + rA[i]]; } } }
        for (int t = 0; t < nt; t += 2) {
            const bool last = (t == nt - 2);
            const size_t o1 = (size_t)(t + 1) * kstep, o2 = (size_t)(t + 2) * kstep;
            const char *a2_0 = last ? nA0 : cA0 + o2, *a2_1 = last ? nA1 : cA1 + o2, *b2_0 = last ? nB0 : cB0 + o2, *b2_1 = last ? nB1 : cB1 + o2;
            const char *a3_0 = a2_0 + kstep, *b3_0 = b2_0 + kstep, *b3_1 = b2_1 + kstep;
            unsigned w0[2], w1[2];
#pragma unroll
            for (int i = 0; i < 2; ++i) { if constexpr (GATHER) { const bool nx_ = last && has_next; w0[i] = nx_ ? (unsigned)nt0[i] * (unsigned)(lda * 2) + voffA[i] : vA0[i]; w1[i] = nx_ ? (unsigned)nt1[i] * (unsigned)(lda * 2) + voffA[i] : vA1[i]; } else { w0[i] = voffA[i]; w1[i] = voffA[i]; } }
            if constexpr (SP2) {
            G8_LDB(B0, 0, 0); G8_LDB(B1, 0, 1); G8_SCHED; G8_LDA(At, 0, 0); G8_STAGE2(G8_SA(1, 1), cA1 + o1, vA1[0], vA1[1]);
            G8_WAIT_V(8); G8_WAIT_L(0); G8_BAR; G8_MMA(0, 0, At, B0); G8_MMA(0, 1, At, B1); G8_BAR; G8_SCHED;
            G8_LDA(At, 0, 1); G8_STAGE(G8_SB(0, 0), b2_0, voffB); G8_STAGE(G8_SB(0, 1), b2_1, voffB); G8_STAGE2(G8_SA(0, 0), a2_0, w0[0], w0[1]);
            G8_WAIT_V(8); G8_WAIT_L(0); G8_BAR; G8_MMA(1, 0, At, B0); G8_MMA(1, 1, At, B1); G8_BAR; G8_SCHED;
            G8_LDB(B0, 1, 0); G8_LDB(B1, 1, 1); G8_SCHED; G8_LDA(At, 1, 0); G8_STAGE2(G8_SA(0, 1), a2_1, w1[0], w1[1]);
            G8_WAIT_V(8); G8_WAIT_L(0); G8_BAR; G8_MMA(0, 0, At, B0); G8_MMA(0, 1, At, B1); G8_BAR; G8_SCHED;
            G8_LDA(At, 1, 1); G8_STAGE(G8_SB(1, 0), b3_0, voffB); G8_STAGE(G8_SB(1, 1), b3_1, voffB); G8_STAGE2(G8_SA(1, 0), a3_0, w0[0], w0[1]);
            G8_WAIT_V(8); G8_WAIT_L(0); G8_BAR; G8_MMA(1, 0, At, B0); G8_MMA(1, 1, At, B1); G8_BAR; G8_SCHED;
            } else {
            G8_LDB(B0, 0, 0); G8_SCHED; G8_LDA(At, 0, 0); G8_STAGE(G8_SA(1, 1), cA1 + o1, voffA);
            G8_WAIT_L(8); G8_BAR; G8_WAIT_L(0); G8_MMA(0, 0, At, B0); G8_BAR; G8_SCHED;
            G8_LDB(B1, 0, 1); G8_STAGE(G8_SB(0, 0), b2_0, voffB);
            G8_BAR; G8_WAIT_L(0); G8_MMA(0, 1, At, B1); G8_BAR;
            G8_LDA(At, 0, 1); G8_STAGE(G8_SA(0, 0), a2_0, voffA);
            G8_BAR; G8_WAIT_L(0); G8_MMA(1, 0, At, B0); G8_BAR; G8_SCHED;
            G8_STAGE(G8_SB(0, 1), b2_1, voffB);
            G8_WAIT_V(6); G8_BAR; G8_MMA(1, 1, At, B1); G8_BAR;
            G8_LDB(B0, 1, 0); G8_SCHED; G8_LDA(At, 1, 0); G8_STAGE(G8_SA(0, 1), a2_1, voffA);
            G8_WAIT_L(8); G8_BAR; G8_WAIT_L(0); G8_MMA(0, 0, At, B0); G8_BAR; G8_SCHED;
            G8_LDB(B1, 1, 1); G8_STAGE(G8_SB(1, 0), b3_0, voffB);
            G8_BAR; G8_WAIT_L(0); G8_MMA(0, 1, At, B1); G8_BAR;
            G8_LDA(At, 1, 1); G8_STAGE(G8_SA(1, 0), a3_0, voffA);
            G8_BAR; G8_WAIT_L(0); G8_MMA(1, 0, At, B0); G8_BAR; G8_SCHED;
            G8_STAGE(G8_SB(1, 1), b3_1, voffB);
            G8_WAIT_V(6); G8_BAR; G8_MMA(1, 1, At, B1); G8_BAR;
            }
        }
        if constexpr (ALIGN_EPI) { if (wr == 0) G8_BAR; }
#pragma unroll
        for (int ai = 0; ai < 2; ++ai)
#pragma unroll
            for (int m = 0; m < 4; ++m) { const int row = cur.row0 + 128 * ai + 64 * wr + 16 * m + fr;
                if constexpr (DUAL) { const f32x4 g0 = acc[ai][0][m][0], g1 = acc[ai][0][m][1], u0 = acc[ai][1][m][0], u1 = acc[ai][1][m][1];
                    const float a[8] = {g0[0], g0[1], g0[2], g0[3], g1[0], g1[1], g1[2], g1[3]}, u[8] = {u0[0], u0[1], u0[2], u0[3], u1[0], u1[1], u1[2], u1[3]};
                    E.store2(row, cur.col0 + 32 * wc + 8 * fq, a, u); }
                else {
#pragma unroll
                    for (int bj = 0; bj < 2; ++bj) { const f32x4 v0 = acc[ai][bj][m][0], v1 = acc[ai][bj][m][1]; const float v[8] = {v0[0], v0[1], v0[2], v0[3], v1[0], v1[1], v1[2], v1[3]};
                        E.store(row, cur.col0 + 128 * bj + 32 * wc + 8 * fq, v); } } }
        if (!has_next) break;
#pragma unroll
        for (int a = 0; a < 2; ++a)
#pragma unroll
            for (int b = 0; b < 2; ++b)
#pragma unroll
                for (int m = 0; m < 4; ++m)
#pragma unroll
                    for (int n = 0; n < 2; ++n) acc[a][b][m][n] = (f32x4){0.f, 0.f, 0.f, 0.f};
        cur = nxt; cA0 = nA0; cA1 = nA1; cB0 = nB0; cB1 = nB1; ++ui;
        if constexpr (GATHER) {
#pragma unroll
            for (int i = 0; i < 2; ++i) { vA0[i] = (unsigned)nt0[i] * (unsigned)(lda * 2) + voffA[i]; vA1[i] = (unsigned)nt1[i] * (unsigned)(lda * 2) + voffA[i]; } }
        if constexpr (ALIGN_EPI) { if (wr == 1) G8_BAR; }
    }
    G8_WAIT_V(0);
    if constexpr (!ALIGN_EPI) { if (wr == 0) G8_BAR; }
    G8_BAR;
#undef G8_SA
#undef G8_SB
#undef G8_STAGE
#undef G8_STAGE2
#undef G8_LDA
#undef G8_LDB
#undef G8_MMA
#undef G8_WAIT_V
#undef G8_WAIT_L
#undef G8_BAR
#undef G8_SCHED
}
struct SchedPlain { TileOrder T; const bf16_t *A, *Bt; int lda, ldb;
    DEVINL bool next(int i, Unit& u) const { int pm, pn; if (!T.tile(i, pm, pn)) return false;
        u.a0 = (const char*)(A + (size_t)pm * 256 * lda); u.a1 = u.a0 + (size_t)128 * lda * 2; u.b0 = (const char*)(Bt + (size_t)pn * 256 * ldb); u.b1 = u.b0 + (size_t)128 * ldb * 2; u.sel = nullptr; u.row0 = pm * 256; u.col0 = pn * 256; return true; } };
struct SchedExpDual { TileOrder T; const bf16_t *A, *Wg, *Wu; const int* SEL;
    DEVINL bool next(int i, Unit& u) const { int pm, pn; if (!T.tile(i, pm, pn)) return false; const size_t wo = ((size_t)(pm >> 2) * FF + (size_t)pn * 128) * DM;
        u.a0 = (const char*)(A + (size_t)(pm & 3) * SEQ * DM); u.a1 = u.a0; u.sel = SEL + pm * 256; u.b0 = (const char*)(Wg + wo); u.b1 = (const char*)(Wu + wo); u.row0 = pm * 256; u.col0 = pn * 128; return true; } };
struct SchedExpDown { TileOrder T; const bf16_t *A, *Wd;
    DEVINL bool next(int i, Unit& u) const { int pm, pn; if (!T.tile(i, pm, pn)) return false; const size_t wo = ((size_t)(pm >> 2) * DM + (size_t)pn * 256) * FF;
        u.a0 = (const char*)(A + (size_t)pm * 256 * FF); u.a1 = u.a0 + (size_t)128 * FF * 2; u.b0 = (const char*)(Wd + wo); u.b1 = u.b0 + (size_t)128 * FF * 2; u.sel = nullptr; u.row0 = pm * 256; u.col0 = pn * 256; return true; } };
}

DEVINL void phase4(const Params& p, const int* pos_, const float* q_head_g_, const float* k_head_g_, int wave, int lane) {
    const int gw = blockIdx.x * NWAVES + wave, NGW = gridDim.x * NWAVES;
    const bf16_t* CQ = (const bf16_t*)(p.ws + WS_CQ); const bf16_t* CKV = (const bf16_t*)(p.ws + WS_CKV); const float* KPE = (const float*)(p.ws + WS_KPE);
    const bf16_t* QR = (const bf16_t*)(p.ws + WS_QRAW); const bf16_t* KVR = (const bf16_t*)(p.ws + WS_KVRAW);
    bf16_t* QF = (bf16_t*)(p.ws + WS_QF); bf16_t* KF = (bf16_t*)(p.ws + WS_KF); bf16_t* VF = (bf16_t*)(p.ws + WS_VF);
    typedef float f32x2 __attribute__((ext_vector_type(2)));
    const int l2 = 2 * lane, lr = l2 & 63, j0 = l2 & 31;
    const float if0 = 1.0f / powf(10000.0f, (float)(2 * j0) / 64.0f), if1 = 1.0f / powf(10000.0f, (float)(2 * j0 + 2) / 64.0f);
    const f32x2 gqn = *(const f32x2*)(q_head_g_ + l2), gkn = *(const f32x2*)(k_head_g_ + l2), gqr = *(const f32x2*)(q_head_g_ + 128 + lr), gkr = *(const f32x2*)(k_head_g_ + 128 + lr);
    const bool rl = lane < 32, second = (lane & 16) != 0;
    for (int row = gw; row < NTOK; row += NGW) {
        const int b = row >> 11, s = row & 2047;
        unsigned qn[8], qr[8], kn[8], vv[8];
#pragma unroll
        for (int h = 0; h < MH; ++h) { const bf16_t* q = QR + (size_t)row * 2048 + h * 256; const bf16_t* kv = KVR + (size_t)row * 2048 + h * 256;
            qn[h] = *(const unsigned*)(q + l2); qr[h] = *(const unsigned*)(q + 128 + lr); kn[h] = *(const unsigned*)(kv + l2); vv[h] = *(const unsigned*)(kv + 128 + l2); }
        const u32x4 cqv = *(const u32x4*)(CQ + (size_t)row * QLORA + 8 * lane); const u32x2 ckv = *(const u32x2*)(CKV + (size_t)row * KVLORA + 4 * lane);
        const f32x2 kpe = *(const f32x2*)(KPE + (size_t)row * ROPE + lr);
        const float posf = (float)pos_[row];
        float sq = 0.f, skv = 0.f;
        { const unsigned w[4] = {cqv.x, cqv.y, cqv.z, cqv.w};
#pragma unroll
          for (int i = 0; i < 4; ++i) { const float a = bf2f(w[i] & 0xffffu), c = bf2f(w[i] >> 16); sq += a * a + c * c; }
          const float a0 = bf2f(ckv.x & 0xffffu), a1 = bf2f(ckv.x >> 16), a2 = bf2f(ckv.y & 0xffffu), a3 = bf2f(ckv.y >> 16); skv = a0 * a0 + a1 * a1 + a2 * a2 + a3 * a3; }
        const float rq = 1.f / sqrtf(wave_sum(sq) * (1.f / QLORA) + EPS), rkv = 1.f / sqrtf(wave_sum(skv) * (1.f / KVLORA) + EPS);
        float sn0, cs0, sn1, cs1; sincosf(posf * if0, &sn0, &cs0); sincosf(posf * if1, &sn1, &cs1);
        const float kp0 = rl ? kpe.x : 0.f, kp1 = rl ? kpe.y : 0.f;
#pragma unroll
        for (int h = 0; h < MH; ++h) {
            { const float v0 = rq * bf2f(qn[h] & 0xffffu), v1 = rq * bf2f(qn[h] >> 16), v2 = rl ? rq * bf2f(qr[h] & 0xffffu) : 0.f, v3 = rl ? rq * bf2f(qr[h] >> 16) : 0.f;
              const float inv = 1.f / sqrtf(wave_sum(v0 * v0 + v1 * v1 + v2 * v2 + v3 * v3) * (1.f / QK) + EPS);
              const float n2 = v2 * inv * gqr.x, n3 = v3 * inv * gqr.y, p2 = __shfl_xor(n2, 16), p3 = __shfl_xor(n3, 16);
              const float r2 = second ? (n2 * cs0 + p2 * sn0) : (n2 * cs0 - p2 * sn0), r3 = second ? (n3 * cs1 + p3 * sn1) : (n3 * cs1 - p3 * sn1);
              bf16_t* o = QF + ((size_t)(b * MH + h) * SEQ + s) * QK; *(unsigned*)(o + l2) = pk2(v0 * inv * gqn.x, v1 * inv * gqn.y); if (rl) *(unsigned*)(o + 128 + lr) = pk2(r2, r3); }
            { const float v0 = rkv * bf2f(kn[h] & 0xffffu), v1 = rkv * bf2f(kn[h] >> 16);
              const float inv = 1.f / sqrtf(wave_sum(v0 * v0 + v1 * v1 + kp0 * kp0 + kp1 * kp1) * (1.f / QK) + EPS);
              const float n2 = kp0 * inv * gkr.x, n3 = kp1 * inv * gkr.y, p2 = __shfl_xor(n2, 16), p3 = __shfl_xor(n3, 16);
              const float r2 = second ? (n2 * cs0 + p2 * sn0) : (n2 * cs0 - p2 * sn0), r3 = second ? (n3 * cs1 + p3 * sn1) : (n3 * cs1 - p3 * sn1);
              bf16_t* o = KF + ((size_t)(b * MH + h) * SEQ + s) * QK; *(unsigned*)(o + l2) = pk2(v0 * inv * gkn.x, v1 * inv * gkn.y); if (rl) *(unsigned*)(o + 128 + lr) = pk2(r2, r3);
              *(unsigned*)(VF + ((size_t)(b * MH + h) * SEQ + s) * MV + l2) = pk2(rkv * bf2f(vv[h] & 0xffffu), rkv * bf2f(vv[h] >> 16)); }
        }
    }
}

DEVINL void attn_naive(const Params& p, LAS unsigned char* lds, int wave, int lane) {
    const bf16_t* QF = (const bf16_t*)(p.ws + WS_QF); const bf16_t* KF = (const bf16_t*)(p.ws + WS_KF); const bf16_t* VF = (const bf16_t*)(p.ws + WS_VF); bf16_t* MIX = (bf16_t*)(p.ws + WS_MIXED);
    LAS float* ql = (LAS float*)(lds + wave * 9216);
    LAS float* pl = ql + 192;
    const int gw = blockIdx.x * NWAVES + wave, NGW = gridDim.x * NWAVES;
    const float scale = 0.07216878364870322f;
    for (int qi = gw; qi < NB * MH * SEQ; qi += NGW) {
        const int bh = qi >> 11, s = qi & 2047, b = bh >> 3, h = bh & 7;
        const bf16_t* q = QF + (size_t)qi * QK; ql[lane] = bf2f(q[lane]); ql[64 + lane] = bf2f(q[64 + lane]); ql[128 + lane] = bf2f(q[128 + lane]);
        LDS_WAIT();
        float mx = -1e30f;
        for (int i = 0; i < 32; ++i) { const bf16_t* k = KF + ((size_t)bh * SEQ + lane + 64 * i) * QK; float a = 0.f;
#pragma unroll
            for (int d = 0; d < QK; d += 8) { float kf[8]; ld8f(k + d, kf);
#pragma unroll
                for (int e = 0; e < 8; ++e) a += kf[e] * ql[d + e]; }
            a *= scale; pl[lane + 64 * i] = a; mx = fmaxf(mx, a); }
#pragma unroll
        for (int o = 1; o < 64; o <<= 1) mx = fmaxf(mx, __shfl_xor(mx, o));
        LDS_WAIT();
        float sum = 0.f;
        for (int i = 0; i < 32; ++i) { const float e = __expf(pl[lane + 64 * i] - mx); sum += e; pl[lane + 64 * i] = e; }
        sum = wave_sum(sum); LDS_WAIT();
        float o0 = 0.f, o1 = 0.f; const bf16_t* v = VF + (size_t)bh * SEQ * MV + 2 * lane;
        for (int kk = 0; kk < SEQ; ++kk) { const unsigned w = *(const unsigned*)(v + (size_t)kk * MV); const float pr = pl[kk]; o0 += pr * bf2f(w & 0xffffu); o1 += pr * bf2f(w >> 16); }
        const float il = 1.f / sum;
        *(unsigned*)(MIX + (size_t)(b * SEQ + s) * DM + HW + h * MV + 2 * lane) = pk2(o0 * il, o1 * il);
        LDS_WAIT();
    }
}

namespace at {
using f32x16 = __attribute__((ext_vector_type(16))) float;
using s16x4 = __attribute__((ext_vector_type(4))) short;
constexpr float SCALE = 0.07216878364870322f;
constexpr float THR = 8.f;
constexpr int KT_BYTES = 64 * 400, VT_BYTES = 64 * MV * 2;
#define AT_KSWZ(row, colB) ((row) * 400 + (colB))
#define AT_SBAR() __builtin_amdgcn_sched_barrier(0)
DEVINL int crow(int r, int hi) { return (r & 3) + 8 * (r >> 2) + 4 * hi; }
DEVINL unsigned cvtpk(float lo, float hi) { unsigned r; asm volatile("v_cvt_pk_bf16_f32 %0, %1, %2" : "=v"(r) : "v"(lo), "v"(hi)); return r; }
DEVINL void partialSM(f32x16& p0, f32x16& p1, float& m_reg, float& mn, float& alpha) {
    constexpr float C = SCALE * 1.4426950408889634f;
    float pmax = p0[0];
#pragma unroll
    for (int r = 1; r < 16; ++r) pmax = fmaxf(pmax, p0[r]);
#pragma unroll
    for (int r = 0; r < 16; ++r) pmax = fmaxf(pmax, p1[r]);
    { auto rr = __builtin_amdgcn_permlane32_swap(__float_as_uint(pmax), __float_as_uint(pmax), false, false); pmax = fmaxf(__uint_as_float(rr[0]), __uint_as_float(rr[1])); }
    if (__builtin_expect(__all(pmax - m_reg <= THR / SCALE), 1)) { mn = m_reg; alpha = 1.f; }
    else { mn = fmaxf(m_reg, pmax); alpha = __builtin_amdgcn_exp2f((m_reg - mn) * C); m_reg = mn; }
    const float mnC = -mn * C;
#pragma unroll
    for (int r = 0; r < 16; ++r) p0[r] = __builtin_amdgcn_exp2f(fmaf(p0[r], C, mnC));
#pragma unroll
    for (int r = 0; r < 16; ++r) p1[r] = __builtin_amdgcn_exp2f(fmaf(p1[r], C, mnC));
}
DEVINL void finishSM(f32x16& p0, f32x16& p1, float alpha, float& l_reg, bf16x8& pa0, bf16x8& pa1, bf16x8& pa2, bf16x8& pa3) {
    float ps = 0;
#pragma unroll
    for (int r = 0; r < 16; ++r) ps += p0[r];
#pragma unroll
    for (int r = 0; r < 16; ++r) ps += p1[r];
    { auto rr = __builtin_amdgcn_permlane32_swap(__float_as_uint(ps), __float_as_uint(ps), false, false); ps = __uint_as_float(rr[0]) + __uint_as_float(rr[1]); }
    l_reg = l_reg * alpha + ps;
#define AT_PK4(P, BASE, OUT) do { unsigned a0 = cvtpk(P[BASE + 0], P[BASE + 1]), a1 = cvtpk(P[BASE + 2], P[BASE + 3]);   \
    unsigned b0 = cvtpk(P[BASE + 4], P[BASE + 5]), b1 = cvtpk(P[BASE + 6], P[BASE + 7]);                              \
    auto r0 = __builtin_amdgcn_permlane32_swap(a0, b0, false, false); auto r1 = __builtin_amdgcn_permlane32_swap(a1, b1, false, false); \
    u32x4 w = {r0[0], r1[0], r0[1], r1[1]}; OUT = *reinterpret_cast<bf16x8*>(&w); } while (0)
    AT_PK4(p0, 0, pa0); AT_PK4(p0, 8, pa1); AT_PK4(p1, 0, pa2); AT_PK4(p1, 8, pa3);
#undef AT_PK4
}
DEVINL void qkt(f32x16& p0, f32x16& p1, const LAS char* Ks, const bf16x8* qr, int r32, int hi) {
    p0 = f32x16{}; p1 = f32x16{};
#pragma unroll
    for (int d0 = 0; d0 < 12; ++d0) { const int cb = (d0 * 16 + hi * 8) * 2;
        const bf16x8 b0 = *reinterpret_cast<const LAS bf16x8*>(Ks + AT_KSWZ(r32, cb));
        const bf16x8 b1 = *reinterpret_cast<const LAS bf16x8*>(Ks + AT_KSWZ(32 + r32, cb));
        p0 = __builtin_amdgcn_mfma_f32_32x32x16_bf16(b0, qr[d0], p0, 0, 0, 0);
        p1 = __builtin_amdgcn_mfma_f32_32x32x16_bf16(b1, qr[d0], p1, 0, 0, 0); }
}
DEVINL int v_st(int k, int c) { const int kk = (k & ~0xC) | ((k & 4) << 1) | ((k & 8) >> 1); return ((kk >> 3) * 4 + (c >> 5)) * 512 + ((kk & 7) * 32 + (c & 31)) * 2; }
DEVINL int v_rd_base(int lane) { return ((lane & 3) << 3) | (((lane >> 2) & 3) << 6) | (((lane >> 4) & 1) << 5) | (((lane >> 5) & 1) << 8); }
constexpr int v_rd_off(int d0, int ks, int half) { return d0 * 512 + ks * 4096 + half * 2048; }
template <int OFF> DEVINL s16x4 tr_read(int vb) { s16x4 r; asm volatile("ds_read_b64_tr_b16 %0, %1 offset:%2" : "=&v"(r) : "v"(vb), "i"(OFF) : "memory"); return r; }
template <int D0> DEVINL void pv_one(f32x16& od, int vb, bf16x8 pa0, bf16x8 pa1, bf16x8 pa2, bf16x8 pa3) {
    const s16x4 l0 = tr_read<v_rd_off(D0, 0, 0)>(vb), h0 = tr_read<v_rd_off(D0, 0, 1)>(vb), l1 = tr_read<v_rd_off(D0, 1, 0)>(vb), h1 = tr_read<v_rd_off(D0, 1, 1)>(vb);
    const s16x4 l2 = tr_read<v_rd_off(D0, 2, 0)>(vb), h2 = tr_read<v_rd_off(D0, 2, 1)>(vb), l3 = tr_read<v_rd_off(D0, 3, 0)>(vb), h3 = tr_read<v_rd_off(D0, 3, 1)>(vb);
    asm volatile("s_waitcnt lgkmcnt(0)" ::: "memory"); AT_SBAR();
#define AT_PK(L, H) (bf16x8){L[0], L[1], L[2], L[3], H[0], H[1], H[2], H[3]}
    od = __builtin_amdgcn_mfma_f32_32x32x16_bf16(pa0, AT_PK(l0, h0), od, 0, 0, 0);
    od = __builtin_amdgcn_mfma_f32_32x32x16_bf16(pa1, AT_PK(l1, h1), od, 0, 0, 0);
    od = __builtin_amdgcn_mfma_f32_32x32x16_bf16(pa2, AT_PK(l2, h2), od, 0, 0, 0);
    od = __builtin_amdgcn_mfma_f32_32x32x16_bf16(pa3, AT_PK(l3, h3), od, 0, 0, 0);
#undef AT_PK
}
DEVINL void attn_unit(const bf16_t* Qb, const bf16_t* Kh, const bf16_t* Vh, bf16_t* Ob, LAS char* lds) {
    const int tid = threadIdx.x, wid = tid >> 6, lane = tid & 63, r32 = lane & 31, hi = lane >> 5;
    LAS char* K_lds = lds; LAS char* V_lds = lds + KT_BYTES; LAS float* wsf = (LAS float*)(lds + KT_BYTES + VT_BYTES) + wid * 64; LAS float* li_l = wsf; LAS float* al_l = wsf + 32;
    float m_reg = -1e30f, l_reg = 0.f; f32x16 o[4] = {}; bf16x8 qr[12];
    const bf16_t* Qw = Qb + (size_t)(wid * 32 + r32) * QK + hi * 8;
#pragma unroll
    for (int d0 = 0; d0 < 12; ++d0) qr[d0] = *reinterpret_cast<const bf16x8*>(Qw + d0 * 16);
    const int vb0 = (int)(uintptr_t)V_lds + v_rd_base(lane);
    bf16x8 ks[3], vs[2];
    int kdst[3], vdst[2];
#pragma unroll
    for (int i = 0; i < 3; ++i) { const int c = tid + 512 * i, key = c / 24, ch = c % 24; kdst[i] = AT_KSWZ(key, ch * 16); }
#pragma unroll
    for (int i = 0; i < 2; ++i) { const int c = tid + 512 * i, key = c >> 4, ch = c & 15; vdst[i] = v_st(key, ch * 8); }
#define AT_LOAD(k0) do { _Pragma("unroll") for (int i = 0; i < 3; ++i) ks[i] = *reinterpret_cast<const bf16x8*>(Kh + (size_t)(k0) * QK + (size_t)(tid + 512 * i) * 8); \
                         _Pragma("unroll") for (int i = 0; i < 2; ++i) vs[i] = *reinterpret_cast<const bf16x8*>(Vh + (size_t)(k0) * MV + (size_t)(tid + 512 * i) * 8); } while (0)
    AT_LOAD(0);
    constexpr int NT = SEQ / 64;
    for (int j = 0; j < NT; ++j) {
        __syncthreads();
#pragma unroll
        for (int i = 0; i < 3; ++i) *reinterpret_cast<LAS bf16x8*>(K_lds + kdst[i]) = ks[i];
#pragma unroll
        for (int i = 0; i < 2; ++i) *reinterpret_cast<LAS bf16x8*>(V_lds + vdst[i]) = vs[i];
        __syncthreads();
        if (j + 1 < NT) AT_LOAD((j + 1) * 64);
        f32x16 p0, p1; float mn, alpha; bf16x8 pa0, pa1, pa2, pa3;
        qkt(p0, p1, K_lds, qr, r32, hi);
        partialSM(p0, p1, m_reg, mn, alpha);
        if (__any(alpha < 1.f)) { if (hi == 0) al_l[r32] = alpha; asm volatile("s_waitcnt lgkmcnt(0)" ::: "memory");
#pragma unroll
            for (int d = 0; d < 4; ++d)
#pragma unroll
                for (int r = 0; r < 16; ++r) o[d][r] *= al_l[crow(r, hi)]; }
        finishSM(p0, p1, alpha, l_reg, pa0, pa1, pa2, pa3);
        pv_one<0>(o[0], vb0, pa0, pa1, pa2, pa3); pv_one<1>(o[1], vb0, pa0, pa1, pa2, pa3); pv_one<2>(o[2], vb0, pa0, pa1, pa2, pa3); pv_one<3>(o[3], vb0, pa0, pa1, pa2, pa3);
    }
#undef AT_LOAD
    if (hi == 0) li_l[r32] = l_reg; asm volatile("s_waitcnt lgkmcnt(0)" ::: "memory");
    bf16_t* Ow = Ob + (size_t)(wid * 32) * DM;
#pragma unroll
    for (int r = 0; r < 16; ++r) { const int orow = crow(r, hi); const float rl = 1.f / li_l[orow];
#pragma unroll
        for (int d0 = 0; d0 < 4; ++d0) Ow[(size_t)orow * DM + d0 * 32 + r32] = (bf16_t)f2bf(o[d0][r] * rl); }
    __syncthreads();
}
DEVINL void attn_phase(const Params& p, LAS unsigned char* lds) {
    const bf16_t* QF = (const bf16_t*)(p.ws + WS_QF); const bf16_t* KF = (const bf16_t*)(p.ws + WS_KF); const bf16_t* VF = (const bf16_t*)(p.ws + WS_VF); bf16_t* MIX = (bf16_t*)(p.ws + WS_MIXED);
    const int G = gridDim.x, first = G >= 256 ? 128 : 0, nfree = G - first;
    if ((int)blockIdx.x < first) return;
    for (int u = blockIdx.x - first; u < NB * MH * (SEQ / 256); u += nfree) {
        const int bh = u >> 3, qb = u & 7, b = bh >> 3, h = bh & 7;
        attn_unit(QF + ((size_t)bh * SEQ + qb * 256) * QK, KF + (size_t)bh * SEQ * QK, VF + (size_t)bh * SEQ * MV, MIX + ((size_t)b * SEQ + qb * 256) * DM + HW + h * MV, (LAS char*)lds);
    }
}
}

DEVINL void hgrn_naive(const Params& p, LAS unsigned char* lds, int tid) {
    const bf16_t* HQ = (const bf16_t*)(p.ws + WS_HQ); const bf16_t* HI = (const bf16_t*)(p.ws + WS_HI);
    const int sub = tid >> 8, t2 = tid & 255, v = t2 & 127, kh = t2 >> 7; constexpr int TC = 16;
    LAS float* fl = (LAS float*)lds + sub * (4 * TC * 128); LAS float* qlds = fl + TC * 128; LAS float* po = qlds + TC * 128;
    for (int cg2 = blockIdx.x; cg2 < 32; cg2 += gridDim.x) {
        const int chain = cg2 * 2 + sub, b = chain >> 4, dir = (chain >> 3) & 1, h = chain & 7;
        const float* G = (const float*)(p.ws + (dir ? WS_GB : WS_GF)); bf16_t* O = (bf16_t*)(p.ws + (dir ? WS_OB : WS_OF));
        float S[64];
#pragma unroll
        for (int k = 0; k < 64; ++k) S[k] = 0.f;
        for (int c0 = 0; c0 < SEQ; c0 += TC) {
            __syncthreads();
            for (int i = t2; i < TC * 128; i += 256) { const int tt = i >> 7, k = i & 127; const int t = dir ? (SEQ - 1 - (c0 + tt)) : (c0 + tt); const size_t row = (size_t)b * SEQ + t;
                fl[i] = __builtin_amdgcn_exp2f(G[row * HW + h * 128 + k]); qlds[i] = bf2f(HQ[row * HW + h * 128 + k]); }
            __syncthreads();
            for (int tt = 0; tt < TC; ++tt) { const int t = dir ? (SEQ - 1 - (c0 + tt)) : (c0 + tt); const size_t row = (size_t)b * SEQ + t;
                const float vv = bf2f(HI[row * HW + h * 128 + v]); float o = 0.f;
#pragma unroll
                for (int k = 0; k < 64; ++k) { const float f = fl[tt * 128 + kh * 64 + k]; S[k] = f * S[k] + (1.f - f) * vv; o += S[k] * qlds[tt * 128 + kh * 64 + k]; }
                po[(tt * 2 + kh) * 128 + v] = o; }
            __syncthreads();
            for (int i = t2; i < TC * 128; i += 256) { const int tt = i >> 7, vv2 = i & 127; const int t = dir ? (SEQ - 1 - (c0 + tt)) : (c0 + tt); const size_t row = (size_t)b * SEQ + t;
                O[row * HW + h * 128 + vv2] = (bf16_t)f2bf(po[(tt * 2) * 128 + vv2] + po[(tt * 2 + 1) * 128 + vv2]); }
        }
    }
}

namespace hg {
using at::f32x16; using at::s16x4;
constexpr int QIMG = 0, KIMG = 17408, QHIMG = 34816, KTIMG = 52224, VIMG = 70656, SIMG = 87040, QOFF = 121856, EBL = 125952;
constexpr float LOG2E = 1.4426950408889634f;
#define HG_SWZ256(row, colB) ((row) * 272 + (colB))
#define HG_SWZ128(row, colB) ((row) * 144 + (colB))
#define HG_BAR() asm volatile("s_waitcnt lgkmcnt(0)\n\ts_barrier" ::: "memory")
template <bool STATE>
DEVINL void hgrn_loop(const Params& p, LAS char* lds, int chain, int wid, int lane) {
    const int b = chain >> 4, dir = (chain >> 3) & 1, h = chain & 7;
    const float* G = (const float*)(p.ws + (dir ? WS_GB : WS_GF)); bf16_t* O = (bf16_t*)(p.ws + (dir ? WS_OB : WS_OF));
    const bf16_t* HQ = (const bf16_t*)(p.ws + WS_HQ); const bf16_t* HI = (const bf16_t*)(p.ws + WS_HI);
    const int tid = threadIdx.x, r32 = lane & 31, hi = lane >> 5;
    const int tq = wid, k2 = 2 * lane, colbase = h * 128, vt = wid & 3;
    LAS float* qoff = (LAS float*)(lds + QOFF); LAS float* ebl = (LAS float*)(lds + EBL);
    typedef float f32x2 __attribute__((ext_vector_type(2)));
    f32x16 st[4] = {};
    f32x2 gl[8]; unsigned ql[8]; bf16x8 vs[2];
#define HG_LOAD(n_) do { int nn_ = __builtin_amdgcn_readfirstlane(n_); asm volatile("" : "+s"(nn_)); _Pragma("unroll") for (int i = 0; i < 8; ++i) { const int tau = 8 * tq + i, t = dir ? (SEQ - 1 - (64 * nn_ + tau)) : (64 * nn_ + tau); const size_t ro = ((size_t)b * SEQ + t) * HW + colbase + k2; gl[i] = *reinterpret_cast<const f32x2*>(G + ro); ql[i] = *reinterpret_cast<const unsigned*>(HQ + ro); } \
        _Pragma("unroll") for (int i2 = 0; i2 < 2; ++i2) { const int c = tid + 512 * i2, tau = c >> 4, ch = c & 15, t = dir ? (SEQ - 1 - (64 * nn_ + tau)) : (64 * nn_ + tau); vs[i2] = *reinterpret_cast<const bf16x8*>(HI + ((size_t)b * SEQ + t) * HW + colbase + ch * 8); } } while (0)
    HG_LOAD(0);
    for (int n = 0; n < SEQ / 64; ++n) {
        f32x2 pre[8]; f32x2 run = {0.f, 0.f};
#pragma unroll
        for (int i = 0; i < 8; ++i) { run += gl[i]; pre[i] = run; }
        *reinterpret_cast<LAS f32x2*>(qoff + tq * 128 + k2) = run;
        __builtin_amdgcn_sched_barrier(0); HG_BAR(); __builtin_amdgcn_sched_barrier(0);
        f32x2 off = {0.f, 0.f}, ref2 = {0.f, 0.f}, bl2 = {0.f, 0.f};
#pragma unroll
        for (int j = 0; j < 8; ++j) { const f32x2 tj = *reinterpret_cast<const LAS f32x2*>(qoff + j * 128 + k2); if (j < tq) off += tj; if (j < 4) ref2 += tj; bl2 += tj; }
        const f32x2 eref = {__builtin_amdgcn_exp2f(ref2.x), __builtin_amdgcn_exp2f(ref2.y)}, ebr = {__builtin_amdgcn_exp2f(bl2.x - ref2.x), __builtin_amdgcn_exp2f(bl2.y - ref2.y)};
        if (tq == 0) *reinterpret_cast<LAS f32x2*>(ebl + k2) = (f32x2){__builtin_amdgcn_exp2f(bl2.x), __builtin_amdgcn_exp2f(bl2.y)};
        unsigned kpa[8], kpb[8];
#pragma unroll
        for (int i = 0; i < 8; ++i) { const int tau = 8 * tq + i; const f32x2 b2 = pre[i] + off, d = b2 - ref2;
            const float fa = __builtin_amdgcn_exp2f(gl[i].x), fb = __builtin_amdgcn_exp2f(gl[i].y), kka = 1.f - fa, kkb = 1.f - fb;
            const float e1a = __builtin_amdgcn_exp2f(fminf(d.x, 120.f)), e1b = __builtin_amdgcn_exp2f(fminf(d.y, 120.f)), ia = __builtin_amdgcn_exp2f(fminf(-d.x, 120.f)), ib = __builtin_amdgcn_exp2f(fminf(-d.y, 120.f));
            const float qa = bf2f(ql[i] & 0xffffu), qb = bf2f(ql[i] >> 16), qta = qa * e1a, qtb = qb * e1b, kta = kka * ia, ktb = kkb * ib;
            const int o = HG_SWZ256(tau, 2 * k2);
            *reinterpret_cast<LAS unsigned*>(lds + QIMG + o) = pk2(qta, qtb); *reinterpret_cast<LAS unsigned*>(lds + KIMG + o) = pk2(kta, ktb);
            *reinterpret_cast<LAS unsigned*>(lds + QHIMG + o) = pk2(qta * eref.x, qtb * eref.y); kpa[i] = __float_as_uint(kta * ebr.x); kpb[i] = __float_as_uint(ktb * ebr.y); }
        {
#define HG_P(a, i) pk2(__uint_as_float(a[i]), __uint_as_float(a[i + 1]))
          const u32x4 wa = {HG_P(kpa, 0), HG_P(kpa, 2), HG_P(kpa, 4), HG_P(kpa, 6)}, wb = {HG_P(kpb, 0), HG_P(kpb, 2), HG_P(kpb, 4), HG_P(kpb, 6)};
#undef HG_P
          *reinterpret_cast<LAS u32x4*>(lds + KTIMG + HG_SWZ128(k2, 16 * tq)) = wa; *reinterpret_cast<LAS u32x4*>(lds + KTIMG + HG_SWZ128(k2 + 1, 16 * tq)) = wb; }
#pragma unroll
        for (int i2 = 0; i2 < 2; ++i2) { const int c = tid + 512 * i2, tau = c >> 4, ch = c & 15; *reinterpret_cast<LAS bf16x8*>(lds + VIMG + at::v_st(tau, ch * 8)) = vs[i2]; }
        if constexpr (STATE) {
#pragma unroll
            for (int kt = 0; kt < 4; ++kt)
#pragma unroll
                for (int g = 0; g < 4; ++g) { const int k0 = 32 * kt + 8 * g + 4 * hi, v = 32 * vt + r32; u32x2 w; w.x = pk2(st[kt][4 * g], st[kt][4 * g + 1]); w.y = pk2(st[kt][4 * g + 2], st[kt][4 * g + 3]);
                    *reinterpret_cast<LAS u32x2*>(lds + SIMG + HG_SWZ256(v, 2 * k0)) = w; }
        }
        __builtin_amdgcn_sched_barrier(0); HG_BAR(); __builtin_amdgcn_sched_barrier(0);
        if (n + 1 < SEQ / 64) HG_LOAD(n + 1);
        __builtin_amdgcn_sched_barrier(0);
        if constexpr (!STATE) {
            const int tb = wid & 1, dh = wid >> 1, tl = 32 * tb + r32;
            f32x16 p0 = {}, p1 = {};
#pragma unroll
            for (int d0 = 0; d0 < 8; ++d0) { const int cb = (d0 * 16 + hi * 8) * 2;
                const bf16x8 qf = *reinterpret_cast<const LAS bf16x8*>(lds + QIMG + HG_SWZ256(tl, cb));
                const bf16x8 b0 = *reinterpret_cast<const LAS bf16x8*>(lds + KIMG + HG_SWZ256(r32, cb)), b1 = *reinterpret_cast<const LAS bf16x8*>(lds + KIMG + HG_SWZ256(32 + r32, cb));
                p0 = __builtin_amdgcn_mfma_f32_32x32x16_bf16(b0, qf, p0, 0, 0, 0); p1 = __builtin_amdgcn_mfma_f32_32x32x16_bf16(b1, qf, p1, 0, 0, 0); }
#pragma unroll
            for (int r = 0; r < 16; ++r) { const int sk = at::crow(r, hi); p0[r] = (sk <= tl) ? p0[r] : 0.f; p1[r] = (sk + 32 <= tl) ? p1[r] : 0.f; }
            __builtin_amdgcn_sched_barrier(0);
            bf16x8 pa0, pa1, pa2, pa3;
#define HG_PK4(P, BASE, OUT) do { unsigned a0 = at::cvtpk(P[BASE + 0], P[BASE + 1]), a1 = at::cvtpk(P[BASE + 2], P[BASE + 3]), b0_ = at::cvtpk(P[BASE + 4], P[BASE + 5]), b1_ = at::cvtpk(P[BASE + 6], P[BASE + 7]); \
    auto r0 = __builtin_amdgcn_permlane32_swap(a0, b0_, false, false); auto r1 = __builtin_amdgcn_permlane32_swap(a1, b1_, false, false); u32x4 w = {r0[0], r1[0], r0[1], r1[1]}; OUT = *reinterpret_cast<bf16x8*>(&w); } while (0)
            HG_PK4(p0, 0, pa0); HG_PK4(p0, 8, pa1); HG_PK4(p1, 0, pa2); HG_PK4(p1, 8, pa3);
#undef HG_PK4
            __builtin_amdgcn_sched_barrier(0);
            f32x16 o0 = {}, o1 = {};
            const int vb = (int)(uintptr_t)(lds + VIMG) + at::v_rd_base(lane) + dh * 1024;
            at::pv_one<0>(o0, vb, pa0, pa1, pa2, pa3); at::pv_one<1>(o1, vb, pa0, pa1, pa2, pa3);
#pragma unroll
            for (int s8 = 0; s8 < 8; ++s8) { const int cb = (s8 * 16 + hi * 8) * 2;
                const bf16x8 a = *reinterpret_cast<const LAS bf16x8*>(lds + QHIMG + HG_SWZ256(tl, cb));
                const bf16x8 s0 = *reinterpret_cast<const LAS bf16x8*>(lds + SIMG + HG_SWZ256(64 * dh + r32, cb)), s1 = *reinterpret_cast<const LAS bf16x8*>(lds + SIMG + HG_SWZ256(64 * dh + 32 + r32, cb));
                o0 = __builtin_amdgcn_mfma_f32_32x32x16_bf16(a, s0, o0, 0, 0, 0); o1 = __builtin_amdgcn_mfma_f32_32x32x16_bf16(a, s1, o1, 0, 0, 0); }
            { int nn_ = __builtin_amdgcn_readfirstlane(n); asm volatile("" : "+s"(nn_));
#pragma unroll
              for (int r = 0; r < 16; ++r) { const int tau = 32 * tb + at::crow(r, hi), t = dir ? (SEQ - 1 - (64 * nn_ + tau)) : (64 * nn_ + tau); bf16_t* op = O + ((size_t)b * SEQ + t) * HW + colbase + 64 * dh + r32; op[0] = (bf16_t)(pk2(o0[r], 0.f) & 0xffffu); op[32] = (bf16_t)(pk2(o1[r], 0.f) & 0xffffu); } }
        } else {
#pragma unroll
            for (int kt = 0; kt < 4; ++kt)
#pragma unroll
                for (int g = 0; g < 4; ++g) { const f32x4 e = *reinterpret_cast<const LAS f32x4*>(ebl + 32 * kt + 8 * g + 4 * hi); st[kt][4 * g] *= e.x; st[kt][4 * g + 1] *= e.y; st[kt][4 * g + 2] *= e.z; st[kt][4 * g + 3] *= e.w; }
            const int vb = (int)(uintptr_t)(lds + VIMG) + at::v_rd_base(lane) + vt * 512;
#define HG_U(S4) do { const s16x4 L = at::tr_read<at::v_rd_off(0, S4, 0)>(vb), H = at::tr_read<at::v_rd_off(0, S4, 1)>(vb); asm volatile("s_waitcnt lgkmcnt(0)" ::: "memory"); __builtin_amdgcn_sched_barrier(0); \
    const bf16x8 bf = (bf16x8){L[0], L[1], L[2], L[3], H[0], H[1], H[2], H[3]}; \
    _Pragma("unroll") for (int kt = 0; kt < 4; ++kt) { const bf16x8 a = *reinterpret_cast<const LAS bf16x8*>(lds + KTIMG + HG_SWZ128(32 * kt + r32, (16 * (S4) + 8 * hi) * 2)); st[kt] = __builtin_amdgcn_mfma_f32_32x32x16_bf16(a, bf, st[kt], 0, 0, 0); } } while (0)
            HG_U(0); HG_U(1); HG_U(2); HG_U(3);
#undef HG_U
        }
    }
#undef HG_LOAD
}
DEVINL void hgrn_finalize(const Params& p, const float* hgrn_out_g_, int b, int h, int r0, int nrows, int wave, int lane) {
    const bf16_t* OF = (const bf16_t*)(p.ws + WS_OF); const bf16_t* OB = (const bf16_t*)(p.ws + WS_OB); const bf16_t* HGS = (const bf16_t*)(p.ws + WS_HGS); bf16_t* MIX = (bf16_t*)(p.ws + WS_MIXED);
    const int hl = lane >> 5, c4 = 4 * (lane & 31); const f32x4 g = *(const f32x4*)(hgrn_out_g_ + h * 128 + c4);
    for (int rr = 32 * wave; rr < nrows; rr += 32 * NWAVES) {
        u32x2 a[16], c[16], hg[16];
#pragma unroll
        for (int i = 0; i < 16; ++i) { const size_t o = ((size_t)b * SEQ + r0 + rr + 2 * i + hl) * HW + h * 128 + c4; a[i] = *(const u32x2*)(OF + o); c[i] = *(const u32x2*)(OB + o); hg[i] = *(const u32x2*)(HGS + o); }
#pragma unroll
        for (int i = 0; i < 16; ++i) { const f32x4 v = {bf2f(a[i].x & 0xffffu) + bf2f(c[i].x & 0xffffu), bf2f(a[i].x >> 16) + bf2f(c[i].x >> 16), bf2f(a[i].y & 0xffffu) + bf2f(c[i].y & 0xffffu), bf2f(a[i].y >> 16) + bf2f(c[i].y >> 16)};
            float ss = (v.x * v.x + v.y * v.y) + (v.z * v.z + v.w * v.w);
#pragma unroll
            for (int o = 1; o < 32; o <<= 1) ss += __shfl_xor(ss, o);
            const float inv = 1.f / sqrtf(ss * (1.f / HDV) + EPS); u32x2 w;
            w.x = pk2(v.x * inv * g.x * bf2f(hg[i].x & 0xffffu), v.y * inv * g.y * bf2f(hg[i].x >> 16)); w.y = pk2(v.z * inv * g.z * bf2f(hg[i].y & 0xffffu), v.w * inv * g.w * bf2f(hg[i].y >> 16));
            *(u32x2*)(MIX + ((size_t)b * SEQ + r0 + rr + 2 * i + hl) * DM + h * 128 + c4) = w; }
    }
}
DEVINL void hgrn_chain(const Params& p, LAS char* lds, int chain, const float* hgrn_out_g_, bool fused) {
    const int tid = threadIdx.x, wid = __builtin_amdgcn_readfirstlane(tid >> 6), lane = tid & 63;
    if (wid < 4) hgrn_loop<false>(p, lds, chain, wid, lane); else hgrn_loop<true>(p, lds, chain, wid, lane);
    if (!fused) { __syncthreads(); return; }
    const int b = chain >> 4, dir = (chain >> 3) & 1, h = chain & 7;
    asm volatile("s_waitcnt vmcnt(0)" ::: "memory");
    __syncthreads();
    if (tid == 0) { unsigned* cnt = (unsigned*)(p.ws + WS_CTL) + CW_HGCNT + 64 * (b * 8 + h);
        __builtin_amdgcn_fence(__ATOMIC_RELEASE, "agent"); asm volatile("s_waitcnt vmcnt(0)" ::: "memory");
        __hip_atomic_fetch_add(cnt, 1u, __ATOMIC_RELAXED, __HIP_MEMORY_SCOPE_AGENT); }
    __syncthreads();
}
DEVINL void finalize_pool(const Params& p, const float* hgrn_out_g_, LAS int* slot, int tid, int wave, int lane) {
    unsigned* ctl = (unsigned*)(p.ws + WS_CTL);
    for (;;) {
        __syncthreads();
        if (tid == 0) { const int idx = (int)__hip_atomic_fetch_add(ctl + CW_HGQ, 1u, __ATOMIC_RELAXED, __HIP_MEMORY_SCOPE_AGENT);
            if (idx < NB * HH * 8) { unsigned* cnt = ctl + CW_HGCNT + 64 * (idx >> 3); unsigned sp = 0;
                while (__hip_atomic_load(cnt, __ATOMIC_RELAXED, __HIP_MEMORY_SCOPE_AGENT) < 2u) { __builtin_amdgcn_s_sleep(2); if (++sp > (1u << 22)) break; }
                __builtin_amdgcn_fence(__ATOMIC_ACQUIRE, "agent"); asm volatile("s_waitcnt vmcnt(0)" ::: "memory"); }
            *slot = idx; }
        __syncthreads();
        const int idx = *slot; if (idx >= NB * HH * 8) break;
        const int bh = idx >> 3, part = idx & 7; hgrn_finalize(p, hgrn_out_g_, bh >> 3, bh & 7, part * 256, 256, wave, lane);
    }
}
}

DEVINL void phase6(const Params& p, const float* hgrn_out_g_, int wave, int lane) {
    for (int it = blockIdx.x; it < NB * HH * 8; it += gridDim.x) { const int bh = it >> 3, part = it & 7; hg::hgrn_finalize(p, hgrn_out_g_, bh >> 3, bh & 7, part * 256, 256, wave, lane); }
}

DEVINL void phase8(const Params& p, const float* norm2_g_, const float* w_router_, LAS unsigned char* lds, int tid, int wave, int lane) {
    const int gw = blockIdx.x * NWAVES + wave, NGW = gridDim.x * NWAVES;
    const float* MOD = (const float*)(p.ws + WS_MOD); bf16_t* H2 = (bf16_t*)(p.ws + WS_H2); float* AFF = (float*)(p.ws + WS_AFF);
    LAS f32x4* wl = (LAS f32x4*)lds;
    for (int i = tid; i < DM * 4; i += NTHR) { const int col = i >> 2, e4 = i & 3, l = (col >> 2) & 63, j = col >> 8, q = col & 3; wl[e4 * 2048 + (4 * j + q) * 64 + l] = *(const f32x4*)(w_router_ + (size_t)col * NE + 4 * e4); }
    __syncthreads();
    for (int row = gw; row < NTOK; row += NGW) {
        const int b = row >> 11, s = row & 2047; const f32x4* xr = (const f32x4*)((const float*)(p.ws + WS_X1) + (size_t)row * DM) + lane;
        f32x4 v[8]; float ss = 0.f;
#pragma unroll
        for (int j = 0; j < 8; ++j) { v[j] = xr[64 * j]; ss += (v[j].x * v[j].x + v[j].y * v[j].y) + (v[j].z * v[j].z + v[j].w * v[j].w); }
        const float r = 1.f / sqrtf(wave_sum(ss) * (1.f / DM) + EPS);
        f32x4 lg[4];
#pragma unroll
        for (int e = 0; e < 4; ++e) lg[e] = (f32x4){0.f, 0.f, 0.f, 0.f};
        u32x2* o = (u32x2*)(H2 + (size_t)row * DM) + lane;
#pragma unroll
        for (int j = 0; j < 8; ++j) { const int col = 4 * (lane + 64 * j);
            const f32x4 g = *(const f32x4*)(norm2_g_ + col), sh = *(const f32x4*)(MOD + b * 6 * DM + 3 * DM + col), sc = *(const f32x4*)(MOD + b * 6 * DM + 4 * DM + col);
            const f32x4 h = v[j] * r * g * (sc + 1.f) + sh; u32x2 w; w.x = pk2(h.x, h.y); w.y = pk2(h.z, h.w); o[64 * j] = w;
#pragma unroll
            for (int q = 0; q < 4; ++q)
#pragma unroll
                for (int e4 = 0; e4 < 4; ++e4) lg[e4] += wl[e4 * 2048 + (4 * j + q) * 64 + lane] * h[q];
            __builtin_amdgcn_sched_barrier(0); }
        float l16[16];
#pragma unroll
        for (int e = 0; e < 16; ++e) l16[e] = wave_sum(lg[e >> 2][e & 3]);
        float mx = l16[0];
#pragma unroll
        for (int e = 1; e < 16; ++e) mx = fmaxf(mx, l16[e]);
        float sum = 0.f;
#pragma unroll
        for (int e = 0; e < 16; ++e) { l16[e] = __expf(l16[e] - mx); sum += l16[e]; }
        const float is = 1.f / sum; float mine = 0.f;
#pragma unroll
        for (int e = 0; e < 16; ++e) mine = (lane == e) ? l16[e] * is : mine;
        if (lane < 16) AFF[((size_t)b * NE + lane) * SEQ + s] = mine;
    }
    __syncthreads();
}

DEVINL int wg_sum9(int c, LAS int* red, int par, int wave, int lane) {
    if (lane == 0) red[par * 8 + wave] = c;
    asm volatile("s_waitcnt lgkmcnt(0)" ::: "memory"); __builtin_amdgcn_s_barrier(); asm volatile("" ::: "memory");
    const LAS int* r = red + par * 8; return (r[0] + r[1]) + (r[2] + r[3]) + (r[4] + r[5]) + (r[6] + r[7]);
}
DEVINL void phase9(const Params& p, LAS unsigned char* lds, int tid, int wave, int lane) {
    const unsigned* AFFB = (const unsigned*)(p.ws + WS_AFF); float* GATE = (float*)(p.ws + WS_GATE); short* INV = (short*)(p.ws + WS_INV); int* SEL = (int*)(p.ws + WS_SEL);
    LAS int* red = (LAS int*)lds;
    for (int be = blockIdx.x; be < NB * NE; be += gridDim.x) {
        const int b = be >> 4, e = be & 15;
        __syncthreads();
        const u32x4 xv = *(const u32x4*)(AFFB + (size_t)be * SEQ + 4 * tid);
        unsigned T = 0u; int par = 0;
        for (int bit = 30; bit >= 0; --bit) { const unsigned cand = T | (1u << bit);
            const int c = __builtin_popcountll(__ballot(xv.x >= cand)) + __builtin_popcountll(__ballot(xv.y >= cand)) + __builtin_popcountll(__ballot(xv.z >= cand)) + __builtin_popcountll(__ballot(xv.w >= cand));
            if (wg_sum9(c, red, par, wave, lane) >= CAP) T = cand; par ^= 1; }
        const int cgt = wg_sum9(__builtin_popcountll(__ballot(xv.x > T)) + __builtin_popcountll(__ballot(xv.y > T)) + __builtin_popcountll(__ballot(xv.z > T)) + __builtin_popcountll(__ballot(xv.w > T)), red, par, wave, lane); par ^= 1;
        const int need_eq = CAP - cgt;
        const unsigned xs[4] = {xv.x, xv.y, xv.z, xv.w};
        int eqc = 0;
#pragma unroll
        for (int j = 0; j < 4; ++j) eqc += (xs[j] == T) ? 1 : 0;
        int inc = eqc;
#pragma unroll
        for (int o = 1; o < 64; o <<= 1) { const int t = __shfl_up(inc, o); if (lane >= o) inc += t; }
        LAS int* woff = red + 16;
        if (lane == 63) woff[wave] = inc;
        asm volatile("s_waitcnt lgkmcnt(0)" ::: "memory"); __builtin_amdgcn_s_barrier(); asm volatile("" ::: "memory");
        int eqbase = inc - eqc;
        for (int w = 0; w < wave; ++w) eqbase += woff[w];
        int selc = 0; bool selj[4];
#pragma unroll
        for (int j = 0; j < 4; ++j) { const bool eq = xs[j] == T; selj[j] = (xs[j] > T) || (eq && eqbase < need_eq); eqbase += eq ? 1 : 0; selc += selj[j] ? 1 : 0; }
        int inc2 = selc;
#pragma unroll
        for (int o = 1; o < 64; o <<= 1) { const int t = __shfl_up(inc2, o); if (lane >= o) inc2 += t; }
        if (lane == 63) woff[8 + wave] = inc2;
        asm volatile("s_waitcnt lgkmcnt(0)" ::: "memory"); __builtin_amdgcn_s_barrier(); asm volatile("" ::: "memory");
        int slot = inc2 - selc;
        for (int w = 0; w < wave; ++w) slot += woff[8 + w];
#pragma unroll
        for (int j = 0; j < 4; ++j) { const int s = 4 * tid + j; short inv = -1;
            if (selj[j]) { inv = (short)slot; GATE[(e * 4 + b) * CAP + slot] = __uint_as_float(xs[j]); SEL[(e * 4 + b) * CAP + slot] = s; ++slot; }
            INV[((size_t)b * SEQ + s) * NE + e] = inv; }
    }
}

DEVINL void phase12(const Params& p, float* out_, int wave, int lane) {
    const int gw = blockIdx.x * NWAVES + wave, NGW = gridDim.x * NWAVES;
    const float* MOD = (const float*)(p.ws + WS_MOD); const short* INV = (const short*)(p.ws + WS_INV); const bf16_t* Y = (const bf16_t*)(p.ws + WS_Y);
    for (int row = gw; row < NTOK; row += NGW) {
        const int b = row >> 11; f32x4 acc[8];
        const int myinv = (lane < NE) ? (int)INV[(size_t)row * NE + lane] : -1;
        f32x4* o = (f32x4*)(out_ + (size_t)row * DM) + lane; const f32x4* xi = (const f32x4*)((const float*)(p.ws + WS_X1) + (size_t)row * DM) + lane; f32x4 x1[8];
#pragma unroll
        for (int j = 0; j < 8; ++j) { acc[j] = (f32x4){0.f, 0.f, 0.f, 0.f}; x1[j] = xi[64 * j]; }
        unsigned long long m = __ballot(myinv >= 0);
        while (m) { const int e = __builtin_ctzll(m); m &= m - 1; const int slot = __builtin_amdgcn_readlane(myinv, e);
            const u32x2* y = (const u32x2*)(Y + ((size_t)(e * 4 + b) * CAP + slot) * DM) + lane; u32x2 w[8];
#pragma unroll
            for (int j = 0; j < 8; ++j) w[j] = y[64 * j];
#pragma unroll
            for (int j = 0; j < 8; ++j) acc[j] += (f32x4){bf2f(w[j].x & 0xffffu), bf2f(w[j].x >> 16), bf2f(w[j].y & 0xffffu), bf2f(w[j].y >> 16)}; }
#pragma unroll
        for (int j = 0; j < 8; ++j) { const int col = 4 * (lane + 64 * j); const f32x4 g = *(const f32x4*)(MOD + b * 6 * DM + 5 * DM + col); o[64 * j] = x1[j] + g * acc[j]; }
    }
}

constexpr int NPHASES = 13;
__global__ void __launch_bounds__(NTHR, 2) mk_fwd(Params p) {
    extern __shared__ __attribute__((aligned(16))) unsigned char lds_raw[];
    LAS unsigned char* lds = (LAS unsigned char*)lds_raw;
    const int tid = threadIdx.x, lane = tid & 63, wave = __builtin_amdgcn_readfirstlane(tid >> 6);
    unsigned char* ws = p.ws;
#if MK_ONE_LAUNCH
    if (tid < 16) ((LAS unsigned*)(lds + MISC_OFF))[tid] = 0u;
    LAS unsigned long long* pst = (LAS unsigned long long*)(lds + MISC_OFF + 64);
    if (tid == 0) { pst[0] = (unsigned long long)p.x; pst[1] = (unsigned long long)p.pos; pst[2] = (unsigned long long)p.q_head_g; pst[3] = (unsigned long long)p.k_head_g; pst[4] = (unsigned long long)p.hgrn_out_g;
        pst[5] = (unsigned long long)p.norm2_g; pst[6] = (unsigned long long)p.w_router; pst[7] = (unsigned long long)p.out; }
    __syncthreads();
    XcdBarrier xbar = xcd_barrier_post((unsigned*)(ws + WS_CTL) + CW_BAR, (volatile LAS unsigned*)(lds + MISC_OFF) + 8);
#define SEAM0() xcd_barrier(xbar)
#define SEAM() xcd_barrier(xbar)
#else
#define SEAM0() do {} while (0)
#define SEAM() do {} while (0)
#endif
#ifdef ONLY_PHASE
#define IN(k) ((k) == ONLY_PHASE)
#else
#ifdef ONLY_PHASE
#define IN(k) ((k) == ONLY_PHASE)
#else
#define IN(k) (p.ph_lo <= (k) && (k) < p.ph_hi)
#endif
#endif
#define BOTH(k) (IN(k) && IN((k) + 1))
#ifndef DUPMASK
#define DUPMASK 0
#endif
#define REP(k) for (int rep_ = 0; rep_ < 1 + ((DUPMASK >> (k)) & 1); ++rep_)
#define DUP_HGRN ((DUPMASK >> 20) & 1)
#define DUP_ATTN ((DUPMASK >> 21) & 1)
    if (IN(0)) { REP(0) { phase0(p, lds, tid, wave, lane); __syncthreads(); } }
    if (IN(1)) {
#if MK_ONE_LAUNCH
        if (IN(0)) {
            if (tid == 0) { unsigned* cnt = (unsigned*)(ws + WS_CTL) + CW_MODCNT; unsigned sp = 0;
                while (__hip_atomic_load(cnt, __ATOMIC_RELAXED, __HIP_MEMORY_SCOPE_AGENT) < (unsigned)(6 * DM / 48)) { __builtin_amdgcn_s_sleep(2); if (++sp > (1u << 22)) break; }
                __builtin_amdgcn_fence(__ATOMIC_ACQUIRE, "agent"); asm volatile("s_waitcnt vmcnt(0)" ::: "memory"); }
            __syncthreads(); }
#endif
        REP(1) phase1(p, wave, lane); if (BOTH(1)) SEAM(); }
#ifndef MFMA_GEMM
#define MFMA_GEMM 1
#endif
#ifndef MFMA_ATTN
#define MFMA_ATTN 1
#endif
#ifndef MFMA_HGRN
#define MFMA_HGRN 1
#endif
    if (IN(2)) { EpiProj E{ws};
#if MFMA_GEMM
        const int ns2 = (gridDim.x >= 256 && CV_P2_END > CV_P0_END) ? NS2 : 0;
        if ((int)blockIdx.x < ns2) stream_items(p, lds, CW_SQ2, CV_P0_END, CV_P2_END, blockIdx.x, ns2, wave, lane);
        else { g8::SchedPlain S; S.T.init(NTOK / 256, DINP / 256, gridDim.x - ns2, blockIdx.x - ns2, (DUPMASK >> 2) & 1); S.A = (const bf16_t*)(ws + WS_H); S.Bt = (const bf16_t*)(ws + WS_WIN); S.lda = DM; S.ldb = DM;
            g8::gemm_phase<false>(lds, DM, DM, DM, S, E); stream_items(p, lds, CW_SQ2, CV_P0_END, CV_P2_END, 0, 1, wave, lane); }
        if (ns2 == 0) stream_items(p, lds, CW_SQ2, CV_P0_END, CV_P2_END, blockIdx.x, gridDim.x, wave, lane);
#else
        naive_gemm<false>((const bf16_t*)(ws + WS_H), DM, (const bf16_t*)(ws + WS_WIN), nullptr, DM, 0, NTOK, DINP, DM, E, wave, lane);
#endif
        if (BOTH(2)) SEAM(); }
    if (IN(3)) { EpiBf16 Eq{(bf16_t*)(ws + WS_QRAW), 2048}; EpiBf16 Ek{(bf16_t*)(ws + WS_KVRAW), 2048};
#if MFMA_GEMM
        { g8::SchedPlain S; S.T.init(NTOK / 256, 8, gridDim.x, blockIdx.x, (DUPMASK >> 3) & 1); S.A = (const bf16_t*)(ws + WS_CQ); S.Bt = (const bf16_t*)(ws + WS_WQ); S.lda = QLORA; S.ldb = QLORA; g8::gemm_phase<false>(lds, QLORA, QLORA, QLORA, S, Eq); }
        { g8::SchedPlain S; S.T.init(NTOK / 256, 8, gridDim.x, blockIdx.x, (DUPMASK >> 3) & 1); S.A = (const bf16_t*)(ws + WS_CKV); S.Bt = (const bf16_t*)(ws + WS_WKV); S.lda = KVLORA; S.ldb = KVLORA; g8::gemm_phase<false>(lds, KVLORA, KVLORA, KVLORA, S, Ek); }
#else
        naive_gemm<false>((const bf16_t*)(ws + WS_CQ), QLORA, (const bf16_t*)(ws + WS_WQ), nullptr, QLORA, 0, NTOK, 2048, QLORA, Eq, wave, lane);
        naive_gemm<false>((const bf16_t*)(ws + WS_CKV), KVLORA, (const bf16_t*)(ws + WS_WKV), nullptr, KVLORA, 0, NTOK, 2048, KVLORA, Ek, wave, lane);
#endif
        if (BOTH(3)) SEAM(); }
    if (IN(4)) { { const int* pos_ = (const int*)ldptr(pst, 1); const float* qg = (const float*)ldptr(pst, 2); const float* kg = (const float*)ldptr(pst, 3); REP(4) phase4(p, pos_, qg, kg, wave, lane); } if (BOTH(4)) SEAM(); }
    if (IN(5)) {
#if MFMA_HGRN
        if (gridDim.x >= 256) { if (blockIdx.x < 64) hg::hgrn_chain(p, (LAS char*)lds, blockIdx.x, (const float*)ldptr(pst, 4), HG_FUSED != 0); else if (blockIdx.x < 128) stream_items(p, lds, CW_SQ5, CV_P2_END, CONV_ALL, blockIdx.x - 64, 64, wave, lane); }
        else { for (int ch = blockIdx.x; ch < 64; ch += gridDim.x) hg::hgrn_chain(p, (LAS char*)lds, ch, nullptr, false); stream_items(p, lds, CW_SQ5, CV_P2_END, CONV_ALL, blockIdx.x, gridDim.x, wave, lane); }
        __syncthreads();
#else
        hgrn_naive(p, lds, tid); __syncthreads();
#endif
        if (DUP_HGRN) { for (int ch = blockIdx.x; ch < 64; ch += gridDim.x) hg::hgrn_chain(p, (LAS char*)lds, ch, nullptr, false); } if (DUP_ATTN) { at::attn_phase(p, lds); __syncthreads(); }
#if MFMA_ATTN
        at::attn_phase(p, lds);
#else
        attn_naive(p, lds, wave, lane);
#endif
        if (HG_FUSED && MK_ONE_LAUNCH && gridDim.x >= 256) { hg::finalize_pool(p, (const float*)ldptr(pst, 4), (LAS int*)(lds + MISC_OFF + 128), tid, wave, lane);
            if (blockIdx.x < 64 || blockIdx.x >= 128) { __syncthreads(); stream_items(p, lds, CW_SQ5, CV_P2_END, CONV_ALL, 0, 1, wave, lane); } }
        if (BOTH(5)) SEAM(); }
    if (IN(6) && !(HG_FUSED && MK_ONE_LAUNCH && gridDim.x >= 256)) { { const float* hg_ = (const float*)ldptr(pst, 4); REP(6) phase6(p, hg_, wave, lane); } if (BOTH(6)) SEAM(); }
    if (IN(7)) { EpiOut E{(const float*)ldptr(pst, 0), (const float*)(ws + WS_MOD), (float*)(ws + WS_X1)};
#if MFMA_GEMM
        g8::SchedPlain S; S.T.init(NTOK / 256, DM / 256, gridDim.x, blockIdx.x, (DUPMASK >> 7) & 1); S.A = (const bf16_t*)(ws + WS_MIXED); S.Bt = (const bf16_t*)(ws + WS_WOUT); S.lda = DM; S.ldb = DM;
        g8::gemm_phase<false>(lds, DM, DM, DM, S, E);
#else
        naive_gemm<false>((const bf16_t*)(ws + WS_MIXED), DM, (const bf16_t*)(ws + WS_WOUT), nullptr, DM, 0, NTOK, DM, DM, E, wave, lane);
#endif
        if (BOTH(7)) SEAM(); }
    if (IN(8)) { { const float* n2 = (const float*)ldptr(pst, 5); const float* wr_ = (const float*)ldptr(pst, 6); REP(8) phase8(p, n2, wr_, lds, tid, wave, lane); } if (BOTH(8)) SEAM(); }
    if (IN(9)) { REP(9) { phase9(p, lds, tid, wave, lane); __syncthreads(); } if (BOTH(9)) SEAM(); }
    if (IN(10)) { EpiSwiglu E{(bf16_t*)(ws + WS_HMID)};
#if MFMA_GEMM
        g8::SchedExpDual S; S.T.init(NSLOTROWS / 256, FF / 128, gridDim.x, blockIdx.x, (DUPMASK >> 10) & 1); S.A = (const bf16_t*)(ws + WS_H2); S.Wg = (const bf16_t*)(ws + WS_WG); S.Wu = (const bf16_t*)(ws + WS_WU); S.SEL = (const int*)(ws + WS_SEL);
        g8::gemm_phase<true, EpiSwiglu, g8::SchedExpDual, true>(lds, DM, DM, DM, S, E);
#else
        naive_gemm<true>((const bf16_t*)(ws + WS_XE), DM, (const bf16_t*)(ws + WS_WG), (const bf16_t*)(ws + WS_WU), DM, (size_t)FF * DM, NSLOTROWS, FF, DM, E, wave, lane);
#endif
        if (BOTH(10)) SEAM(); }
    if (IN(11)) { EpiDown E{(bf16_t*)(ws + WS_Y), (const float*)(ws + WS_GATE)};
#if MFMA_GEMM
        g8::SchedExpDown S; S.T.init(NSLOTROWS / 256, DM / 256, gridDim.x, blockIdx.x, (DUPMASK >> 11) & 1); S.A = (const bf16_t*)(ws + WS_HMID); S.Wd = (const bf16_t*)(ws + WS_WD);
        g8::gemm_phase<false>(lds, FF, FF, FF, S, E);
#else
        naive_gemm<false>((const bf16_t*)(ws + WS_HMID), FF, (const bf16_t*)(ws + WS_WD), nullptr, FF, (size_t)DM * FF, NSLOTROWS, DM, FF, E, wave, lane);
#endif
        if (BOTH(11)) SEAM(); }
    if (IN(12)) { { float* out_ = (float*)ldptr(pst, 7); REP(12) phase12(p, out_, wave, lane); } }
#undef IN
#undef BOTH
}

extern "C" void kernel_launch(void* const* d_in, const int* in_sizes, int n_in, void* d_out, int out_size, void* d_ws, size_t ws_size, hipStream_t stream) {
    static int grid = 0;
    if (grid == 0) {
        if (n_in != 21 || in_sizes[0] != NTOK * DM || out_size != NTOK * DM || ws_size < WS_END) { fprintf(stderr, "kernel_launch: unexpected shapes (n_in %d, in0 %d, out %d, ws %zu < %zu)\n", n_in, n_in > 0 ? in_sizes[0] : -1, out_size, ws_size, (size_t)WS_END); grid = -1; return; }
        int dev = 0, cus = 0, per_cu = 0;
        if (hipGetDevice(&dev) != hipSuccess || hipDeviceGetAttribute(&cus, hipDeviceAttributeMultiprocessorCount, dev) != hipSuccess) { grid = -1; return; }
        if (hipFuncSetAttribute((const void*)mk_fwd, hipFuncAttributeMaxDynamicSharedMemorySize, LDS_BYTES) != hipSuccess) { fprintf(stderr, "kernel_launch: hipFuncSetAttribute failed\n"); grid = -1; return; }
        if (hipOccupancyMaxActiveBlocksPerMultiprocessor(&per_cu, (const void*)mk_fwd, NTHR, LDS_BYTES) != hipSuccess || per_cu < 1) { fprintf(stderr, "kernel_launch: occupancy query says %d blocks per CU\n", per_cu); per_cu = 1; }
        (void)hipGetLastError();
        grid = cus;
    }
    if (grid < 0) return;
    (void)hipMemsetAsync((char*)d_ws + WS_CTL, 0, CTL_ZERO_BYTES, stream);
    Params p{};
    p.x = (const float*)d_in[0]; p.c = (const float*)d_in[1]; p.pos = (const int*)d_in[2]; p.w_ada = (const float*)d_in[3]; p.b_ada = (const float*)d_in[4]; p.norm1_g = (const float*)d_in[5];
    p.w_in = (const float*)d_in[6]; p.lb_logits = (const float*)d_in[7]; p.hgrn_out_g = (const float*)d_in[8]; p.qa_norm_g = (const float*)d_in[9]; p.w_uq = (const float*)d_in[10]; p.kva_norm_g = (const float*)d_in[11];
    p.w_ukv = (const float*)d_in[12]; p.q_head_g = (const float*)d_in[13]; p.k_head_g = (const float*)d_in[14]; p.w_out = (const float*)d_in[15]; p.norm2_g = (const float*)d_in[16]; p.w_router = (const float*)d_in[17];
    p.w_gate = (const float*)d_in[18]; p.w_up = (const float*)d_in[19]; p.w_down = (const float*)d_in[20]; p.out = (float*)d_out; p.ws = (unsigned char*)d_ws;
#if MK_ONE_LAUNCH
    p.ph_lo = 0; p.ph_hi = NPHASES;
    void* args[] = {&p};
    hipError_t e = hipLaunchCooperativeKernel((const void*)mk_fwd, dim3(grid), dim3(NTHR), args, LDS_BYTES, stream);
    if (e != hipSuccess) fprintf(stderr, "kernel_launch: cooperative launch failed: %s (grid %d)\n", hipGetErrorString(e), grid);
#else
    for (int ph = 0; ph < NPHASES; ++ph) { p.ph_lo = ph; p.ph_hi = ph + 1; hipLaunchKernelGGL(mk_fwd, dim3(grid), dim3(NTHR), LDS_BYTES, stream, p); }
    const hipError_t le = hipPeekAtLastError(); if (le != hipSuccess) fprintf(stderr, "kernel_launch: launch failed: %s\n", hipGetErrorName(le));
#endif
}
```

```cpp
#include <hip/hip_runtime.h>
#include <hip/hip_cooperative_groups.h>
#include <cstdio>
#include <cstdint>
namespace cg = cooperative_groups;

#ifndef MK_ONE_LAUNCH
#define MK_ONE_LAUNCH 1
#endif

#define DEVINL __device__ __forceinline__
#define LAS __attribute__((address_space(3)))
typedef unsigned short bf16_t;
typedef float f32x4 __attribute__((ext_vector_type(4)));
typedef unsigned u32x4 __attribute__((ext_vector_type(4)));
typedef unsigned u32x2 __attribute__((ext_vector_type(2)));
typedef short bf16x8 __attribute__((ext_vector_type(8)));

constexpr int NB = 4, SEQ = 2048, DM = 2048, NTOK = NB * SEQ;
constexpr int HH = 8, HDK = 128, HDV = 128, HW = 1024;
constexpr int MH = 8, QLORA = 512, KVLORA = 256, NOPE = 128, ROPE = 64, MV = 128, QK = 192;
constexpr int DIN = 5952, DINP = 6144;
constexpr int NE = 16, CAP = 256, FF = 2048, NSLOTROWS = NB * NE * CAP;
constexpr float EPS = 1e-6f;
constexpr int NWAVES = 8, NTHR = 512;
#ifndef EXP_BAUX
#define EXP_BAUX 0
#endif
#ifndef HG_FUSED
#define HG_FUSED 1
#endif
#ifndef NS2
#define NS2 102
#endif
#ifndef CV_P0_END
#define CV_P0_END 2048
#endif
#ifndef CV_P2_END
#define CV_P2_END 34816
#endif
constexpr int CONV_E1 = 1024, CONV_M = 16 * CONV_E1, CONV_ALL = 3 * CONV_M;
constexpr int GV_NC = 64, GV_ALL = 6 * DM / GV_NC, GV_EARLY = 2 * DM / GV_NC;
constexpr int CONV_END5 = CONV_ALL + CONV_E1;

constexpr size_t al256(size_t x) { return (x + 255) / 256 * 256; }
constexpr size_t WS_CTL = 0, CTL_BYTES = 1u << 20, CTL_ZERO_BYTES = 32768;
constexpr size_t WS_MOD = WS_CTL + CTL_BYTES;
constexpr size_t WS_LB = WS_MOD + al256((size_t)NB * 6 * DM * 4);
constexpr size_t WS_WIN = WS_LB + al256(2 * 1024 * 4);
constexpr size_t WS_WQ = WS_WIN + (size_t)DINP * DM * 2;
constexpr size_t WS_WKV = WS_WQ + (size_t)2048 * QLORA * 2;
constexpr size_t WS_WOUT = WS_WKV + (size_t)2048 * KVLORA * 2;
constexpr size_t WS_WG = WS_WOUT + (size_t)DM * DM * 2;
constexpr size_t WS_WU = WS_WG + (size_t)NE * FF * DM * 2;
constexpr size_t WS_WD = WS_WU + (size_t)NE * FF * DM * 2;
constexpr size_t WS_ACT = WS_WD + (size_t)NE * FF * DM * 2;
constexpr size_t WS_H = WS_ACT;
constexpr size_t WS_HQ = WS_H + (size_t)NTOK * DM * 2;
constexpr size_t WS_GF = WS_HQ + (size_t)NTOK * HW * 2;
constexpr size_t WS_GB = WS_GF + (size_t)NTOK * HW * 4;
constexpr size_t WS_HI = WS_GB + (size_t)NTOK * HW * 4;
constexpr size_t WS_HGS = WS_HI + (size_t)NTOK * HW * 2;
constexpr size_t WS_CQ = WS_HGS + (size_t)NTOK * HW * 2;
constexpr size_t WS_CKV = WS_CQ + (size_t)NTOK * QLORA * 2;
constexpr size_t WS_KPE = WS_CKV + (size_t)NTOK * KVLORA * 2;
constexpr size_t WS_QRAW = WS_KPE + (size_t)NTOK * ROPE * 4;
constexpr size_t WS_KVRAW = WS_QRAW + (size_t)NTOK * 2048 * 2;
constexpr size_t WS_QF = WS_KVRAW + (size_t)NTOK * 2048 * 2;
constexpr size_t WS_KF = WS_QF + (size_t)NB * MH * SEQ * QK * 2;
constexpr size_t WS_VF = WS_KF + (size_t)NB * MH * SEQ * QK * 2;
constexpr size_t WS_OF = WS_VF + (size_t)NB * MH * SEQ * MV * 2;
constexpr size_t WS_OB = WS_OF + (size_t)NTOK * HW * 4;
constexpr size_t WS_MIXED = WS_OB + (size_t)NTOK * HW * 4;
constexpr size_t WS_MIX_END = WS_MIXED + (size_t)NTOK * DM * 2;
constexpr size_t WS_H2 = WS_H;
constexpr size_t WS_XE = WS_HQ;
constexpr size_t WS_HMID = WS_XE + (size_t)NSLOTROWS * DM * 2;
constexpr size_t WS_Y = WS_HMID + (size_t)NSLOTROWS * FF * 2;
constexpr size_t WS_AFF = WS_Y + (size_t)NSLOTROWS * DM * 2;
constexpr size_t WS_GATE = WS_AFF + (size_t)NB * NE * SEQ * 4;
constexpr size_t WS_INV = WS_GATE + (size_t)NSLOTROWS * 4;
constexpr size_t WS_SEL = WS_INV + (size_t)NB * SEQ * NE * 2;
constexpr size_t WS_FFN_END = WS_SEL + (size_t)NSLOTROWS * 4;
constexpr size_t WS_X1 = al256(WS_MIX_END > WS_FFN_END ? WS_MIX_END : WS_FFN_END);
constexpr size_t WS_END = WS_X1 + (size_t)NTOK * DM * 4;
static_assert(WS_ACT % 256 == 0 && WS_END < (size_t)1020 * 1024 * 1024, "d_ws map");

#ifndef X1_BF16
#define X1_BF16 1
#endif
#ifndef ATT_PRIO
#define ATT_PRIO 1
#endif
#ifndef TP_OFF
#define TP_OFF 0
#endif
#ifndef GEMM_B3
#define GEMM_B3 0
#endif
constexpr int LDS_BYTES = GEMM_B3 ? 163840 : 147456;

DEVINL float bf2f(unsigned b) { return __uint_as_float(b << 16); }
DEVINL unsigned f2bf(float f) { unsigned u = __float_as_uint(f); return (u + 0x7fffu + ((u >> 16) & 1u)) >> 16; }
typedef float f32x2_t __attribute__((ext_vector_type(2))); typedef __bf16 bf16x2_t __attribute__((ext_vector_type(2)));
DEVINL unsigned pk2(float lo, float hi) { f32x2_t v = {lo, hi}; bf16x2_t b = __builtin_convertvector(v, bf16x2_t); return __builtin_bit_cast(unsigned, b); }
template <int CTRL> DEVINL float dpp_mov(float v) { return __builtin_bit_cast(float, __builtin_amdgcn_update_dpp(0, __builtin_bit_cast(int, v), CTRL, 0xf, 0xf, false)); }
DEVINL float row_sum16(float v) { v += dpp_mov<0x140>(v); v += dpp_mov<0x141>(v); v += dpp_mov<0xB1>(v); v += dpp_mov<0x4E>(v); return v; }
DEVINL float rdlane(float v, int l) { return __builtin_bit_cast(float, __builtin_amdgcn_readlane(__builtin_bit_cast(int, v), l)); }
DEVINL float wave_sum(float v) { v = row_sum16(v); return (rdlane(v, 0) + rdlane(v, 16)) + (rdlane(v, 32) + rdlane(v, 48)); }
DEVINL unsigned dpp_ror8(unsigned v) { return (unsigned)__builtin_amdgcn_update_dpp(0, (int)v, 0x128, 0xf, 0xf, false); }
DEVINL float sum_xor16(float v) { const auto r = __builtin_amdgcn_permlane16_swap(__builtin_bit_cast(unsigned, v), __builtin_bit_cast(unsigned, v), false, false); return __builtin_bit_cast(float, (unsigned)r[0]) + __builtin_bit_cast(float, (unsigned)r[1]); }
DEVINL float sum_xor32(float v) { const auto r = __builtin_amdgcn_permlane32_swap(__builtin_bit_cast(unsigned, v), __builtin_bit_cast(unsigned, v), false, false); return __builtin_bit_cast(float, (unsigned)r[0]) + __builtin_bit_cast(float, (unsigned)r[1]); }
DEVINL float get_xor16(float v, bool odd_row) { const auto r = __builtin_amdgcn_permlane16_swap(__builtin_bit_cast(unsigned, v), __builtin_bit_cast(unsigned, v), false, false); return __builtin_bit_cast(float, odd_row ? (unsigned)r[0] : (unsigned)r[1]); }
DEVINL void wave_sum16(const float (&v)[16], float (&out)[16]) {
    float u[8], w[4];
#pragma unroll
    for (int i = 0; i < 8; ++i) { const auto r = __builtin_amdgcn_permlane32_swap(__builtin_bit_cast(unsigned, v[2 * i]), __builtin_bit_cast(unsigned, v[2 * i + 1]), false, false);
        u[i] = __builtin_bit_cast(float, (unsigned)r[0]) + __builtin_bit_cast(float, (unsigned)r[1]); }
#pragma unroll
    for (int m = 0; m < 4; ++m) { const auto r = __builtin_amdgcn_permlane16_swap(__builtin_bit_cast(unsigned, u[2 * m]), __builtin_bit_cast(unsigned, u[2 * m + 1]), false, false);
        w[m] = row_sum16(__builtin_bit_cast(float, (unsigned)r[0]) + __builtin_bit_cast(float, (unsigned)r[1])); }
#pragma unroll
    for (int m = 0; m < 4; ++m) { out[4 * m] = rdlane(w[m], 0); out[4 * m + 2] = rdlane(w[m], 16); out[4 * m + 1] = rdlane(w[m], 32); out[4 * m + 3] = rdlane(w[m], 48); }
}
DEVINL float sigmoidf_(float z) { return __builtin_amdgcn_rcpf(1.f + __builtin_amdgcn_exp2f(-1.4426950408889634f * z)); }
#define LDS_WAIT() asm volatile("s_waitcnt lgkmcnt(0)" ::: "memory")

DEVINL const void* ldptr(const LAS unsigned long long* st, int i) { const unsigned long long v = st[i]; const unsigned lo = __builtin_amdgcn_readfirstlane((unsigned)v), hi = __builtin_amdgcn_readfirstlane((unsigned)(v >> 32)); return (const void*)(((unsigned long long)hi << 32) | lo); }
struct Params {
    const float *x, *c; const int* pos;
    const float *w_ada, *b_ada, *norm1_g, *w_in, *lb_logits, *hgrn_out_g, *qa_norm_g, *w_uq, *kva_norm_g, *w_ukv, *q_head_g, *k_head_g, *w_out, *norm2_g, *w_router, *w_gate, *w_up, *w_down;
    float* out; unsigned char* ws; int ph_lo, ph_hi;
};
#define KAOFF(field) ((int)__builtin_offsetof(Params, field))
DEVINL const void* kaptr(int byte_off) { const __attribute__((address_space(4))) char* ka = (const __attribute__((address_space(4))) char*)__builtin_amdgcn_kernarg_segment_ptr(); asm volatile("" : "+s"(ka));
    return (const void*)*(const __attribute__((address_space(4))) unsigned long long*)(ka + byte_off); }

#define XB_TMO      128
#define XB_XCNT(j)  (256  + 64 * (j))
#define XB_XSUB(j)  (1280 + 64 * (j))
#define XB_XGEN(j)  (2304 + 64 * (j))
#define XB_TOP      3328
#define XB_TOPGEN   3392
#define XCD_BAR_WORDS 3456
#define XB_SPIN_CAP (1u << 18)
constexpr int CW_MODCNT = 64, CW_HGQ = 96, CW_SQ2 = 2240, CW_SQ5 = 2304, CW_GVQ = 2432, CW_HGCNT = 128;
constexpr int CW_BAR = 4096;
constexpr int MISC_OFF = 131072;
DEVINL unsigned xb_ld(unsigned* p)              { return __hip_atomic_load(p, __ATOMIC_RELAXED, __HIP_MEMORY_SCOPE_AGENT); }
DEVINL unsigned xb_add(unsigned* p, unsigned v) { return __hip_atomic_fetch_add(p, v, __ATOMIC_RELAXED, __HIP_MEMORY_SCOPE_AGENT); }
DEVINL unsigned xb_xcc_id() { return (unsigned)__builtin_amdgcn_s_getreg((3 << 11) | 20) & 0xFu; }
#define XB_SPIN(cond, bar) do { unsigned _sp = 0; while (cond) { __builtin_amdgcn_s_sleep(1); \
    if ((++_sp & 255u) == 0u) { if (xb_ld(&(bar)[XB_TMO])) break; if (_sp > XB_SPIN_CAP) { atomicAdd(&(bar)[XB_TMO], 1u); break; } } } } while (0)
struct XcdBarrier { unsigned* bar; unsigned x; volatile LAS unsigned* st; };
DEVINL XcdBarrier xcd_barrier_post(unsigned* bar, volatile LAS unsigned* st) {
    XcdBarrier b; b.bar = bar; b.x = xb_xcc_id(); b.st = st;
    if (threadIdx.x == 0) (void)xb_add(&bar[XB_XCNT(b.x)], 1u);
    return b;
}
DEVINL void xcd_barrier_complete(unsigned* bar, unsigned x, unsigned& nloc, unsigned& nx) {
    const unsigned G = gridDim.x * gridDim.y * gridDim.z;
    unsigned sum, cnt, mine, sp = 0u;
    for (;;) {
        sum = 0u; cnt = 0u; mine = 0u;
#pragma unroll
        for (unsigned j = 0; j < 16; ++j) { const unsigned c = xb_ld(&bar[XB_XCNT(j)]); sum += c; cnt += (c > 0u) ? 1u : 0u; mine = (j == x) ? c : mine; }
        if (sum == G) break;
        __builtin_amdgcn_s_sleep(1);
        if ((++sp & 255u) == 0u) { if (xb_ld(&bar[XB_TMO])) break; if (sp > XB_SPIN_CAP) { atomicAdd(&bar[XB_TMO], 1u); break; } }
    }
    nloc = mine > 0u ? mine : 1u; nx = cnt > 0u ? cnt : 1u;
}
DEVINL void xcd_barrier(const XcdBarrier& b) {
    asm volatile("s_waitcnt vmcnt(0)" ::: "memory");
    __syncthreads();
    if (threadIdx.x == 0) {
        unsigned* bar = b.bar;
        __builtin_amdgcn_s_waitcnt(0);
        unsigned nloc = b.st[0], nx = b.st[1];
        if (nloc == 0u) { xcd_barrier_complete(bar, b.x, nloc, nx); b.st[0] = nloc; b.st[1] = nx; }
        const unsigned old = xb_add(&bar[XB_XSUB(b.x)], 1u);
        const unsigned gen = old / nloc;
        if (old + 1u == (gen + 1u) * nloc) {
            __builtin_amdgcn_fence(__ATOMIC_RELEASE, "agent");
            asm volatile("s_waitcnt vmcnt(0)" ::: "memory");
            const unsigned og = xb_add(&bar[XB_TOP], 1u);
            const unsigned tg = og / nx;
            if (og + 1u == (tg + 1u) * nx) xb_add(&bar[XB_TOPGEN], 1u);
            else XB_SPIN(xb_ld(&bar[XB_TOPGEN]) == tg, bar);
            __builtin_amdgcn_fence(__ATOMIC_ACQUIRE, "agent");
            xb_add(&bar[XB_XGEN(b.x)], 1u);
            asm volatile("s_waitcnt vmcnt(0)" ::: "memory");
        } else {
            XB_SPIN(xb_ld(&bar[XB_TOPGEN]) == gen, bar);
            __builtin_amdgcn_fence(__ATOMIC_ACQUIRE, "agent");
            asm volatile("s_waitcnt vmcnt(0)" ::: "memory");
        }
    }
    __syncthreads();
}

DEVINL void p0_transpose_item(const float* W, int ldn, int K, int Ncols, bf16_t* WT, const float* kscale, LAS float* scr, int item, int lane) {
    const int nblk = Ncols / 32, kb = item / nblk, nb = item % nblk, k0 = 64 * kb, n0 = 32 * nb;
#pragma unroll 8
    for (int i = 0; i < 32; ++i) { const int kk = 2 * i + (lane >> 5); float v = W[(size_t)(k0 + kk) * ldn + n0 + (lane & 31)]; if (kscale) v *= kscale[k0 + kk]; scr[kk * 33 + (lane & 31)] = v; }
    LDS_WAIT();
    const int c = lane & 7;
#pragma unroll
    for (int j = 0; j < 4; ++j) { const int n = (lane >> 3) + 8 * j; const LAS float* s = scr + (8 * c) * 33 + n;
        u32x4 o; o.x = pk2(s[0 * 33], s[1 * 33]); o.y = pk2(s[2 * 33], s[3 * 33]); o.z = pk2(s[4 * 33], s[5 * 33]); o.w = pk2(s[6 * 33], s[7 * 33]);
        *(u32x4*)(WT + (size_t)(n0 + n) * K + k0 + 8 * c) = o; }
    LDS_WAIT();
}

#define P0_X(r) ((((r) >> 1) & 1) | ((((r) >> 3) & 1) << 1))
DEVINL void t64_load(const float* src, int ldn, f32x4 (&v)[16], int lane) {
    const float* s0 = src + (size_t)(lane >> 4) * ldn + 4 * (lane & 15);
#pragma unroll
    for (int i = 0; i < 16; ++i) v[i] = __builtin_nontemporal_load((const f32x4*)(s0 + (size_t)(4 * i) * ldn));
}
DEVINL void t64_process(const f32x4 (&v)[16], bf16_t* dst, int K, LAS unsigned char* scr, int lane) {
    const int g = lane >> 4, i16 = lane & 15;
#pragma unroll
    for (int i = 0; i < 16; ++i) { const int k = 4 * i + g; u32x2 w; w.x = pk2(v[i].x, v[i].y); w.y = pk2(v[i].z, v[i].w);
        *(LAS u32x2*)(scr + k * 128 + ((8 * i16) ^ (P0_X(k) << 5))) = w; }
    LDS_WAIT();
    const int q = i16 >> 2, pp = i16 & 3; const bool lo8 = i16 < 8;
#pragma unroll
    for (int j = 0; j < 4; ++j) {
        u32x4 A[2];
#pragma unroll
        for (int kk = 0; kk < 2; ++kk) { const int r0 = 32 * kk + 8 * g + q, r1 = r0 + 4;
            const int a0 = (int)(uintptr_t)scr + r0 * 128 + ((32 * j + 8 * pp) ^ (P0_X(r0) << 5)), a1 = (int)(uintptr_t)scr + r1 * 128 + ((32 * j + 8 * pp) ^ (P0_X(r1) << 5));
            u32x2 lo, hi; asm volatile("ds_read_b64_tr_b16 %0, %1" : "=v"(lo) : "v"(a0) : "memory"); asm volatile("ds_read_b64_tr_b16 %0, %1" : "=v"(hi) : "v"(a1) : "memory");
            asm volatile("s_waitcnt lgkmcnt(0)" : "+v"(lo), "+v"(hi) :: "memory");
            A[kk] = (u32x4){lo.x, lo.y, hi.x, hi.y}; }
        const u32x4 snd = lo8 ? A[1] : A[0]; u32x4 rcv;
        rcv.x = dpp_ror8(snd.x); rcv.y = dpp_ror8(snd.y); rcv.z = dpp_ror8(snd.z); rcv.w = dpp_ror8(snd.w);
        const int kc = lo8 ? 8 * g : 32 + 8 * g;
        __builtin_nontemporal_store(lo8 ? A[0] : rcv, (u32x4*)(dst + (size_t)(16 * j + (i16 & 7)) * K + kc));
        __builtin_nontemporal_store(lo8 ? rcv : A[1], (u32x4*)(dst + (size_t)(16 * j + 8 + (i16 & 7)) * K + kc)); }
    LDS_WAIT();
}
DEVINL void p0_transpose_tile64(const float* W, int ldn, int K, int Ncols, bf16_t* WT, LAS unsigned char* scr, int item, int lane) {
    const int nblk = Ncols / 64, kb = item / nblk, nb = item % nblk, k0 = 64 * kb, n0 = 64 * nb;
    f32x4 v[16]; t64_load(W + (size_t)k0 * ldn + n0, ldn, v, lane); t64_process(v, WT + (size_t)n0 * K + k0, K, scr, lane);
}
DEVINL void conv_ptrs(const Params& p, int id, const float*& src, bf16_t*& dst) {
    const int m = id / CONV_M, r = id % CONV_M, e = r / CONV_E1, t = r % CONV_E1, kb = t >> 5, nb = t & 31; const size_t eo = (size_t)e * DM * FF;
    const float* W = m == 0 ? p.w_gate : (m == 1 ? p.w_up : (m == 2 ? p.w_down : p.w_out)); bf16_t* WT = (bf16_t*)(p.ws + (m == 0 ? WS_WG : (m == 1 ? WS_WU : (m == 2 ? WS_WD : WS_WOUT))));
    src = W + eo + (size_t)(64 * kb) * 2048 + 64 * nb; dst = WT + eo + (size_t)(64 * nb) * 2048 + 64 * kb;
}
DEVINL void conv_stream(const Params& p, LAS unsigned char* scr, int first, int stride, int end, int lane) {
    if (first >= end) return;
    f32x4 va[16], vb[16]; const float* sa; bf16_t* da; const float* sb; bf16_t* db;
    int it0 = first; conv_ptrs(p, it0, sa, da); t64_load(sa, 2048, va, lane);
    for (;;) {
        const int it1 = it0 + stride; if (it1 < end) { conv_ptrs(p, it1, sb, db); t64_load(sb, 2048, vb, lane); }
        t64_process(va, da, 2048, scr, lane); if (it1 >= end) break;
        it0 = it1 + stride; if (it0 < end) { conv_ptrs(p, it0, sa, da); t64_load(sa, 2048, va, lane); }
        t64_process(vb, db, 2048, scr, lane); if (it0 >= end) break;
    }
}
DEVINL int conv_pop(unsigned* q) { unsigned v = 0; if ((threadIdx.x & 63) == 0) v = __hip_atomic_fetch_add(q, 1u, __ATOMIC_RELAXED, __HIP_MEMORY_SCOPE_AGENT); return (int)__builtin_amdgcn_readfirstlane(v); }
DEVINL void conv_stream_q(const Params& p, LAS unsigned char* scr, unsigned* q, int begin, int end, int lane) {
    f32x4 va[16], vb[16]; const float* sa; bf16_t* da; const float* sb; bf16_t* db;
    int it0 = begin + 2 * conv_pop(q); if (it0 >= end) return;
    conv_ptrs(p, it0, sa, da); t64_load(sa, 2048, va, lane);
    for (;;) {
        const int it1 = it0 + 1; if (it1 < end) { conv_ptrs(p, it1, sb, db); t64_load(sb, 2048, vb, lane); }
        t64_process(va, da, 2048, scr, lane); if (it1 >= end) break;
        it0 = begin + 2 * conv_pop(q); if (it0 < end) { conv_ptrs(p, it0, sa, da); t64_load(sa, 2048, va, lane); }
        t64_process(vb, db, 2048, scr, lane); if (it0 >= end) break;
    }
}
DEVINL void p0_gemv_item(const Params& p, LAS unsigned char* lds, int it, int tid, int wave, int lane) {
    LAS float* sc = (LAS float*)lds;
    LAS float* red = (LAS float*)(lds + 32768);
    for (int i = tid; i < NB * DM; i += NTHR) { const float v = p.c[i]; sc[i] = v / (1.f + __expf(-v)); }
    __syncthreads();
    const int cq = lane & 15, ks = lane >> 4;
    f32x4 acc[4]; for (int b = 0; b < 4; ++b) acc[b] = (f32x4){0.f, 0.f, 0.f, 0.f};
    const float* wp = p.w_ada + (size_t)(256 * wave + ks) * (6 * DM) + GV_NC * it + 4 * cq;
#pragma unroll 16
    for (int i = 0; i < 64; ++i) { const f32x4 w = __builtin_nontemporal_load((const f32x4*)(wp + (size_t)(4 * i) * (6 * DM))); const int k = 256 * wave + 4 * i + ks;
#pragma unroll
        for (int b = 0; b < 4; ++b) acc[b] += w * sc[b * DM + k]; }
#pragma unroll
    for (int b = 0; b < 4; ++b)
#pragma unroll
        for (int j = 0; j < 4; ++j) { acc[b][j] = sum_xor32(sum_xor16(acc[b][j])); }
    if (ks == 0) {
#pragma unroll
        for (int b = 0; b < 4; ++b)
#pragma unroll
            for (int j = 0; j < 4; ++j) red[(wave * 4 + b) * 64 + 4 * cq + j] = acc[b][j]; }
    __syncthreads();
    if (tid < 256) { const int b = tid >> 6, col = tid & 63; float s = p.b_ada[GV_NC * it + col];
#pragma unroll
        for (int w = 0; w < 8; ++w) s += red[(w * 4 + b) * 64 + col];
        ((float*)(p.ws + WS_MOD))[b * 6 * DM + GV_NC * it + col] = s; }
    asm volatile("s_waitcnt vmcnt(0)" ::: "memory");
    __syncthreads();
    if (tid == 0) { __builtin_amdgcn_fence(__ATOMIC_RELEASE, "agent"); asm volatile("s_waitcnt vmcnt(0)" ::: "memory"); __hip_atomic_fetch_add((unsigned*)(p.ws + WS_CTL) + CW_MODCNT, 1u, __ATOMIC_RELAXED, __HIP_MEMORY_SCOPE_AGENT); }
}

DEVINL void gemv_deferred(const Params& p, LAS unsigned char* lds, int tid, int wave, int lane) {
    LAS int* slot = (LAS int*)(lds + 65536);
    for (;;) {
        __syncthreads();
        if (tid == 0) *slot = GV_EARLY + (int)__hip_atomic_fetch_add((unsigned*)(p.ws + WS_CTL) + CW_GVQ, 1u, __ATOMIC_RELAXED, __HIP_MEMORY_SCOPE_AGENT);
        __syncthreads();
        const int it = *slot; if (it >= GV_ALL) break;
        p0_gemv_item(p, lds, it, tid, wave, lane);
    }
    __syncthreads();
}
DEVINL void phase0(const Params& p, LAS unsigned char* lds, int tid, int wave, int lane) {
    const int G = gridDim.x;
    const bool split = G >= 256;
    for (int it = blockIdx.x; it < GV_EARLY; it += G) p0_gemv_item(p, lds, it, tid, wave, lane);
    if (!split) for (int it = GV_EARLY + blockIdx.x; it < GV_ALL; it += G) p0_gemv_item(p, lds, it, tid, wave, lane);
    __syncthreads();
    LAS float* scr = (LAS float*)(lds + wave * 16384);
    const int gw = blockIdx.x * NWAVES + wave, NGW = G * NWAVES;
    const int cw = split ? ((int)blockIdx.x - GV_EARLY) * NWAVES + wave : gw, NCW = split ? (G - GV_EARLY) * NWAVES : NGW;
    constexpr int I_IN = (DM / 64) * (DIN / 64), I_Q1 = (QLORA / 64) * (QK / 32), I_Q = MH * I_Q1, I_KV = (KVLORA / 64) * (2048 / 32), I_OUT = 0  , I_E1 = (DM / 64) * (FF / 64), I_E = NE * I_E1;
    constexpr int NITEMS = I_IN + I_Q + I_KV + I_OUT;
    bf16_t* Win_t = (bf16_t*)(p.ws + WS_WIN); bf16_t* Wq_t = (bf16_t*)(p.ws + WS_WQ); bf16_t* Wkv_t = (bf16_t*)(p.ws + WS_WKV); bf16_t* Wout_t = (bf16_t*)(p.ws + WS_WOUT);
    bf16_t* Wg_t = (bf16_t*)(p.ws + WS_WG); bf16_t* Wu_t = (bf16_t*)(p.ws + WS_WU); bf16_t* Wd_t = (bf16_t*)(p.ws + WS_WD);
    for (int it = cw; it < NITEMS && cw >= 0; it += NCW) {
        int r = it;
        if (r < I_IN) { p0_transpose_tile64(p.w_in, DIN, DM, DIN, Win_t, (LAS unsigned char*)scr, r, lane); continue; } r -= I_IN;
        if (r < I_Q) { const int h = r / I_Q1; p0_transpose_item(p.w_uq + h * QK, MH * QK, QLORA, QK, Wq_t + (size_t)h * 256 * QLORA, p.qa_norm_g, scr, r % I_Q1, lane); continue; } r -= I_Q;
        if (r < I_KV) { p0_transpose_item(p.w_ukv, 2048, KVLORA, 2048, Wkv_t, p.kva_norm_g, scr, r, lane); continue; } r -= I_KV;
        if (r < I_OUT) { p0_transpose_tile64(p.w_out, DM, DM, DM, Wout_t, (LAS unsigned char*)scr, r, lane); continue; } r -= I_OUT;
    }
    if (cw >= 0) conv_stream(p, (LAS unsigned char*)scr, cw, NCW, CV_P0_END, lane);
    const size_t gt = (size_t)blockIdx.x * NTHR + tid, GT = (size_t)G * NTHR;
    const u32x4 z = {0u, 0u, 0u, 0u};
    for (size_t i = gt; i < (size_t)(DINP - DIN) * DM / 8; i += GT) *(u32x4*)(Win_t + (size_t)DIN * DM + i * 8) = z;
    for (size_t i = gt; i < (size_t)MH * 64 * QLORA / 8; i += GT) { const size_t h = i / (64 * QLORA / 8), o = i % (64 * QLORA / 8); *(u32x4*)(Wq_t + (h * 256 + QK) * QLORA + o * 8) = z; }
    for (size_t i = gt; i < 2 * 1024; i += GT) { const int dir = (int)(i >> 10), k = (int)(i & 1023); const float l0 = p.lb_logits[dir * 2048 + k], l1 = p.lb_logits[dir * 2048 + 1024 + k];
        ((float*)(p.ws + WS_LB))[i] = 1.f / (1.f + __expf(l1 - l0)); }
}

DEVINL void stream_items(const Params& p, LAS unsigned char* lds, int qword, int begin, int end, int sidx, int nstream, int wave, int lane) {
    LAS unsigned char* scr = lds + wave * 16384;
    (void)sidx; (void)nstream; conv_stream_q(p, scr, (unsigned*)(p.ws + WS_CTL) + qword, begin, end, lane);
}

DEVINL void phase1(const Params& p, int wave, int lane) {
    const int gw = blockIdx.x * NWAVES + wave, NGW = gridDim.x * NWAVES;
    const float* MOD = (const float*)(p.ws + WS_MOD); bf16_t* H = (bf16_t*)(p.ws + WS_H);
    for (int row = gw; row < NTOK; row += NGW) {
        const int b = row >> 11; const f32x4* xr = (const f32x4*)(p.x + (size_t)row * DM) + lane;
        f32x4 v[8]; float s = 0.f;
#pragma unroll
        for (int j = 0; j < 8; ++j) { v[j] = __builtin_nontemporal_load(xr + 64 * j); s += (v[j].x * v[j].x + v[j].y * v[j].y) + (v[j].z * v[j].z + v[j].w * v[j].w); }
        const float r = __builtin_amdgcn_rsqf(wave_sum(s) * (1.f / DM) + EPS);
        u32x2* o = (u32x2*)(H + (size_t)row * DM) + lane;
#pragma unroll
        for (int j = 0; j < 8; ++j) { const int col = 4 * (lane + 64 * j);
            const f32x4 g = *(const f32x4*)(p.norm1_g + col), sh = *(const f32x4*)(MOD + b * 6 * DM + col), sc = *(const f32x4*)(MOD + b * 6 * DM + DM + col);
            const f32x4 h = v[j] * r * g * (sc + 1.f) + sh; u32x2 w; w.x = pk2(h.x, h.y); w.y = pk2(h.z, h.w); o[64 * j] = w; }
    }
}

DEVINL void st_bf16x8(bf16_t* dst, const float (&v)[8]) { u32x4 w; w.x = pk2(v[0], v[1]); w.y = pk2(v[2], v[3]); w.z = pk2(v[4], v[5]); w.w = pk2(v[6], v[7]); *(u32x4*)dst = w; }
struct EpiProj {
    unsigned char* ws;
    DEVINL void store(int row, int col, const float (&v)[8]) const {
        if (col < 1024) { st_bf16x8((bf16_t*)(ws + WS_HQ) + (size_t)row * HW + col, v); }
        else if (col < 3072) { const int dir = (col - 1024) >> 10, k = (col - 1024) & 1023; const float* lb = (const float*)(ws + WS_LB) + dir * 1024 + k; float* G = (float*)(ws + (dir ? WS_GB : WS_GF)) + (size_t)row * HW + k;
            float g[8];
#pragma unroll
            for (int j = 0; j < 8; ++j) { const float l = lb[j]; g[j] = __builtin_amdgcn_logf(l + (1.f - l) * sigmoidf_(v[j])); }
            *(f32x4*)G = (f32x4){g[0], g[1], g[2], g[3]}; *(f32x4*)(G + 4) = (f32x4){g[4], g[5], g[6], g[7]}; }
        else if (col < 4096) { st_bf16x8((bf16_t*)(ws + WS_HI) + (size_t)row * HW + (col - 3072), v); }
        else if (col < 5120) { float s[8];
#pragma unroll
            for (int j = 0; j < 8; ++j) s[j] = v[j] * sigmoidf_(v[j]);
            st_bf16x8((bf16_t*)(ws + WS_HGS) + (size_t)row * HW + (col - 4096), s); }
        else if (col < 5632) { st_bf16x8((bf16_t*)(ws + WS_CQ) + (size_t)row * QLORA + (col - 5120), v); }
        else if (col < 5888) { st_bf16x8((bf16_t*)(ws + WS_CKV) + (size_t)row * KVLORA + (col - 5632), v); }
        else if (col < 5952) { float* K = (float*)(ws + WS_KPE) + (size_t)row * ROPE + (col - 5888); *(f32x4*)K = (f32x4){v[0], v[1], v[2], v[3]}; *(f32x4*)(K + 4) = (f32x4){v[4], v[5], v[6], v[7]}; }
    }
};
struct EpiBf16 { bf16_t* O; int ldo; DEVINL void store(int row, int col, const float (&v)[8]) const { st_bf16x8(O + (size_t)row * ldo + col, v); } };
struct EpiOut {
    const float* x; const float* MOD; float* out;
    DEVINL void store(int row, int col, const float (&v)[8]) const { const int b = row >> 11; const float* g = MOD + b * 6 * DM + 2 * DM + col; const float* xr = x + (size_t)row * DM + col; float* o = out + (size_t)row * DM + col;
        const f32x4 g0 = *(const f32x4*)g, g1 = *(const f32x4*)(g + 4), x0 = __builtin_nontemporal_load((const f32x4*)xr), x1 = __builtin_nontemporal_load((const f32x4*)(xr + 4));
        const f32x4 r0 = x0 + g0 * (f32x4){v[0], v[1], v[2], v[3]}, r1 = x1 + g1 * (f32x4){v[4], v[5], v[6], v[7]};
        if (X1_BF16) { const float r[8] = {r0.x, r0.y, r0.z, r0.w, r1.x, r1.y, r1.z, r1.w}; st_bf16x8((bf16_t*)out + (size_t)row * DM + col, r); }
        else { *(f32x4*)o = r0; *(f32x4*)(o + 4) = r1; } }
};
struct EpiSwiglu {
    bf16_t* O;
    DEVINL void store2(int row, int col, const float (&a)[8], const float (&u)[8]) const { float h[8];
#pragma unroll
        for (int j = 0; j < 8; ++j) h[j] = a[j] * sigmoidf_(a[j]) * u[j];
        st_bf16x8(O + (size_t)row * FF + col, h); }
};
struct EpiDown {
    bf16_t* Y; const float* gate;
    DEVINL void store(int row, int col, const float (&v)[8]) const { const float g = gate[row]; float y[8];
#pragma unroll
        for (int j = 0; j < 8; ++j) y[j] = v[j] * g;
        st_bf16x8(Y + (size_t)row * DM + col, y); }
};

DEVINL void ld8f(const bf16_t* p, float (&f)[8]) { const u32x4 w = *(const u32x4*)p; f[0] = bf2f(w.x & 0xffffu); f[1] = bf2f(w.x >> 16); f[2] = bf2f(w.y & 0xffffu); f[3] = bf2f(w.y >> 16); f[4] = bf2f(w.z & 0xffffu); f[5] = bf2f(w.z >> 16); f[6] = bf2f(w.w & 0xffffu); f[7] = bf2f(w.w >> 16); }
template <bool DUAL, class Epi>
DEVINL void naive_gemm(const bf16_t* A, int lda, const bf16_t* Bt, const bf16_t* Bt2, int ldb, size_t estride  , int M, int N, int K, const Epi& E, int wave, int lane) {
    constexpr int RT = DUAL ? 2 : 4;
    const int gw = blockIdx.x * NWAVES + wave, NGW = gridDim.x * NWAVES, ntn = N / 64, ntiles = (M / (8 * RT)) * ntn;
    const int lr = lane >> 3, lc = lane & 7;
    for (int t = gw; t < ntiles; t += NGW) {
        const int r0 = (t / ntn) * (8 * RT) + lr * RT, c0 = (t % ntn) * 64 + lc * 8;
        const size_t eo = estride ? (size_t)(r0 >> 10) * estride : 0;
        const bf16_t* ap = A + (size_t)r0 * lda; const bf16_t* bp = Bt + eo + (size_t)c0 * ldb; const bf16_t* bp2 = DUAL ? Bt2 + eo + (size_t)c0 * ldb : nullptr;
        float acc[RT][8], acc2[RT][8];
#pragma unroll
        for (int i = 0; i < RT; ++i)
#pragma unroll
            for (int j = 0; j < 8; ++j) { acc[i][j] = 0.f; acc2[i][j] = 0.f; }
        for (int k = 0; k < K; k += 8) {
            float a[RT][8];
#pragma unroll
            for (int i = 0; i < RT; ++i) ld8f(ap + (size_t)i * lda + k, a[i]);
#pragma unroll
            for (int j = 0; j < 8; ++j) { float b[8]; ld8f(bp + (size_t)j * ldb + k, b);
#pragma unroll
                for (int i = 0; i < RT; ++i)
#pragma unroll
                    for (int q = 0; q < 8; ++q) acc[i][j] += a[i][q] * b[q];
                if (DUAL) { ld8f(bp2 + (size_t)j * ldb + k, b);
#pragma unroll
                    for (int i = 0; i < RT; ++i)
#pragma unroll
                        for (int q = 0; q < 8; ++q) acc2[i][j] += a[i][q] * b[q]; } }
        }
#pragma unroll
        for (int i = 0; i < RT; ++i) { if constexpr (DUAL) E.store2(r0 + i, c0, acc[i], acc2[i]); else E.store(r0 + i, c0, acc[i]); }
    }
}

namespace g8 {
constexpr int BM = 256, BK = 64, HALF = 128, HTB = HALF * BK * 2  , STAGE_BYTES = 8 * HTB;
__host__ __device__ __forceinline__ int lds_byte(int r, int c) { const int st = (r >> 4) * 2 + (c >> 5), rr = r & 15, cc = c & 31, ob = rr * 64 + cc * 2; return st * 1024 + (ob ^ (((ob >> 9) & 1) << 5)); }
__host__ __device__ __forceinline__ void stage_rc(int b, int& R, int& C) { const int st = b / 1024, sb = b % 1024, swz = sb ^ (((sb >> 9) & 1) << 5); R = (st >> 1) * 16 + swz / 64; C = (st & 1) * 32 + (swz % 64) / 2; }
__host__ __device__ __forceinline__ int perm32(int rho) { const int n = rho >> 4, i = rho & 15; return 8 * (i >> 2) + 4 * n + (i & 3); }
struct Unit { const char *a0, *a1, *b0, *b1; const int* sel; int row0, col0; };
struct TileOrder { int nM, nN, nwg, G, c, dup;
    DEVINL void init(int nM_, int nN_, int G_, int c_, int dup_ = 0) { nM = nM_; nN = nN_; nwg = nM * nN; G = G_; c = c_; dup = dup_; }
    DEVINL bool tile(int i, int& pm, int& pn) const {
        const long L = (long)(i >> dup) * G + c; if (L >= nwg) return false;
        int wgid = (int)L; { const int q = nwg / 8, r = nwg % 8, xcd = wgid % 8, off = wgid / 8; wgid = (xcd < r ? xcd * (q + 1) : r * (q + 1) + (xcd - r) * q) + off; }
        const int nig = 8 * nN, gid = wgid / nig, fm = gid * 8, gsz = (nM - fm) < 8 ? (nM - fm) : 8;
        pm = fm + ((wgid % nig) % gsz); pn = (wgid % nig) / gsz; return true; } };
template <bool DUAL, class Epi, class Sched, bool GATHER = false, int BAUX = 0  , bool SP2 = true, bool ALIGN_EPI = true>
DEVINL void gemm_phase(LAS unsigned char* lds, const int K, const int lda, const int ldb, const Sched& S, const Epi& E) {
    const int tid = threadIdx.x, wid = __builtin_amdgcn_readfirstlane(tid >> 6), lane = tid & 63, wr = wid >> 2, wc = wid & 3, fr = lane & 15, fq = lane >> 4;
    const int nt = K / BK;
    unsigned voffA[2], voffB[2]; int rA[2];
#pragma unroll
    for (int i = 0; i < 2; ++i) { int R, C; stage_rc(tid * 16 + i * 8192, R, C); const int Rb = (R & ~31) + perm32(R & 31); rA[i] = R;
        voffA[i] = GATHER ? (unsigned)C * 2u : (unsigned)(R * lda + C) * 2u; voffB[i] = (unsigned)(Rb * ldb + C) * 2u; }
    unsigned vA0[2], vA1[2]; int nt0[2] = {0, 0}, nt1[2] = {0, 0};
    const size_t kstep = (size_t)(BK * 2);
    const unsigned ldsw = (unsigned)wid * 1024u;
    const int aoff = lds_byte(wr * 64 + fr, fq * 8), boff = lds_byte(wc * 32 + fr, fq * 8);
#define G8_SA(b, h) (((b) * 2 + (h)) * HTB)
#define G8_SB(b, h) ((4 + (b) * 2 + (h)) * HTB)
#define G8_STAGE(bufoff, gbase, voff) do { _Pragma("unroll") for (int _i = 0; _i < 2; ++_i) \
        __builtin_amdgcn_global_load_lds((const unsigned*)((const char*)(gbase) + (voff)[_i]), (LAS unsigned*)(lds + (bufoff) + ldsw + _i * 8192), 16, 0, BAUX); } while (0)
#define G8_STAGE2(bufoff, gbase, v0_, v1_) do { \
        __builtin_amdgcn_global_load_lds((const unsigned*)((const char*)(gbase) + (v0_)), (LAS unsigned*)(lds + (bufoff) + ldsw), 16, 0, 0); \
        __builtin_amdgcn_global_load_lds((const unsigned*)((const char*)(gbase) + (v1_)), (LAS unsigned*)(lds + (bufoff) + ldsw + 8192), 16, 0, 0); } while (0)
#define G8_LDA(dst, b, h) do { _Pragma("unroll") for (int m = 0; m < 4; ++m) _Pragma("unroll") for (int k = 0; k < 2; ++k) dst[m][k] = *(const LAS bf16x8*)(lds + G8_SA(b, h) + aoff + m * 2048 + k * 1024); } while (0)
#define G8_LDB(dst, b, h) do { _Pragma("unroll") for (int n = 0; n < 2; ++n) _Pragma("unroll") for (int k = 0; k < 2; ++k) dst[n][k] = *(const LAS bf16x8*)(lds + G8_SB(b, h) + boff + n * 2048 + k * 1024); } while (0)
#define G8_MMA(ai, bj, At, Bt) do { __builtin_amdgcn_s_setprio(1); _Pragma("unroll") for (int m = 0; m < 4; ++m) _Pragma("unroll") for (int n = 0; n < 2; ++n) _Pragma("unroll") for (int k = 0; k < 2; ++k) \
        acc[ai][bj][m][n] = __builtin_amdgcn_mfma_f32_16x16x32_bf16(Bt[n][k], At[m][k], acc[ai][bj][m][n], 0, 0, 0); __builtin_amdgcn_s_setprio(0); } while (0)
#define G8_WAIT_V(n) asm volatile("s_waitcnt vmcnt(" #n ")" ::: "memory")
#define G8_WAIT_L(n) asm volatile("s_waitcnt lgkmcnt(" #n ")" ::: "memory")
#define G8_BAR __builtin_amdgcn_s_barrier()
#define G8_SCHED __builtin_amdgcn_sched_barrier(0)
    Unit cur, nxt; int ui = 0;
    if (!S.next(0, cur)) return;
    f32x4 acc[2][2][4][2];
#pragma unroll
    for (int a = 0; a < 2; ++a)
#pragma unroll
        for (int b = 0; b < 2; ++b)
#pragma unroll
            for (int m = 0; m < 4; ++m)
#pragma unroll
                for (int n = 0; n < 2; ++n) acc[a][b][m][n] = (f32x4){0.f, 0.f, 0.f, 0.f};
    bf16x8 At[4][2], B0[2][2], B1[2][2];
    const char *cA0 = cur.a0, *cA1 = cur.a1, *cB0 = cur.b0, *cB1 = cur.b1;
    if constexpr (GATHER) {
#pragma unroll
        for (int i = 0; i < 2; ++i) { vA0[i] = (unsigned)cur.sel[rA[i]] * (unsigned)(lda * 2) + voffA[i]; vA1[i] = (unsigned)cur.sel[128 + rA[i]] * (unsigned)(lda * 2) + voffA[i]; } }
    else { vA0[0] = vA1[0] = voffA[0]; vA0[1] = vA1[1] = voffA[1]; }
    if constexpr (SP2) {
        G8_STAGE(G8_SB(0, 0), cB0, voffB); G8_STAGE(G8_SB(0, 1), cB1, voffB); G8_STAGE2(G8_SA(0, 0), cA0, vA0[0], vA0[1]); G8_STAGE2(G8_SA(0, 1), cA1, vA1[0], vA1[1]);
        if (wr == 1) G8_BAR;
        G8_WAIT_V(2); G8_BAR;
        G8_STAGE(G8_SB(1, 0), cB0 + kstep, voffB); G8_STAGE2(G8_SA(1, 0), cA0 + kstep, vA0[0], vA0[1]); G8_STAGE(G8_SB(1, 1), cB1 + kstep, voffB);
        G8_WAIT_V(6); G8_BAR;
    } else {
        G8_STAGE(G8_SB(0, 0), cB0, voffB); G8_STAGE(G8_SA(0, 0), cA0, voffA); G8_STAGE(G8_SB(0, 1), cB1, voffB); G8_STAGE(G8_SA(0, 1), cA1, voffA);
        if (wr == 1) G8_BAR;
        G8_WAIT_V(4); G8_BAR;
        G8_STAGE(G8_SB(1, 0), cB0 + kstep, voffB); G8_STAGE(G8_SA(1, 0), cA0 + kstep, voffA); G8_STAGE(G8_SB(1, 1), cB1 + kstep, voffB);
        G8_WAIT_V(6); G8_BAR;
    }
    for (;;) {
        const bool has_next = S.next(ui + 1, nxt);
        const char *nA0 = has_next ? nxt.a0 : cA0, *nA1 = has_next ? nxt.a1 : cA1, *nB0 = has_next ? nxt.b0 : cB0, *nB1 = has_next ? nxt.b1 : cB1;
        if constexpr (GATHER) { if (has_next) {
#pragma unroll
            for (int i = 0; i < 2; ++i) { nt0[i] = nxt.sel[rA[i]]; nt1[i] = nxt.sel[128 + rA[i]]; } } }
        for (int t = 0; t < nt; t += 2) {
            const bool last = (t == nt - 2);
            const size_t o1 = (size_t)(t + 1) * kstep, o2 = (size_t)(t + 2) * kstep;
            const char *a2_0 = last ? nA0 : cA0 + o2, *a2_1 = last ? nA1 : cA1 + o2, *b2_0 = last ? nB0 : cB0 + o2, *b2_1 = last ? nB1 : cB1 + o2;
            const char *a3_0 = a2_0 + kstep, *b3_0 = b2_0 + kstep, *b3_1 = b2_1 + kstep;
            unsigned w0[2], w1[2];
#pragma unroll
            for (int i = 0; i < 2; ++i) { if constexpr (GATHER) { const bool nx_ = last && has_next; w0[i] = nx_ ? (unsigned)nt0[i] * (unsigned)(lda * 2) + voffA[i] : vA0[i]; w1[i] = nx_ ? (unsigned)nt1[i] * (unsigned)(lda * 2) + voffA[i] : vA1[i]; } else { w0[i] = voffA[i]; w1[i] = voffA[i]; } }
            if constexpr (SP2) {
            G8_LDB(B0, 0, 0); G8_LDB(B1, 0, 1); G8_SCHED; G8_LDA(At, 0, 0); G8_STAGE2(G8_SA(1, 1), cA1 + o1, vA1[0], vA1[1]);
            G8_WAIT_V(8); G8_WAIT_L(0); G8_BAR; G8_MMA(0, 0, At, B0); G8_MMA(0, 1, At, B1); G8_BAR; G8_SCHED;
            G8_LDA(At, 0, 1); G8_STAGE(G8_SB(0, 0), b2_0, voffB); G8_STAGE(G8_SB(0, 1), b2_1, voffB); G8_STAGE2(G8_SA(0, 0), a2_0, w0[0], w0[1]);
            G8_WAIT_V(8); G8_WAIT_L(0); G8_BAR; G8_MMA(1, 0, At, B0); G8_MMA(1, 1, At, B1); G8_BAR; G8_SCHED;
            G8_LDB(B0, 1, 0); G8_LDB(B1, 1, 1); G8_SCHED; G8_LDA(At, 1, 0); G8_STAGE2(G8_SA(0, 1), a2_1, w1[0], w1[1]);
            G8_WAIT_V(8); G8_WAIT_L(0); G8_BAR; G8_MMA(0, 0, At, B0); G8_MMA(0, 1, At, B1); G8_BAR; G8_SCHED;
            G8_LDA(At, 1, 1); G8_STAGE(G8_SB(1, 0), b3_0, voffB); G8_STAGE(G8_SB(1, 1), b3_1, voffB); G8_STAGE2(G8_SA(1, 0), a3_0, w0[0], w0[1]);
            G8_WAIT_V(8); G8_WAIT_L(0); G8_BAR; G8_MMA(1, 0, At, B0); G8_MMA(1, 1, At, B1); G8_BAR; G8_SCHED;
            } else {
            G8_LDB(B0, 0, 0); G8_SCHED; G8_LDA(At, 0, 0); G8_STAGE(G8_SA(1, 1), cA1 + o1, voffA);
            G8_WAIT_L(8); G8_BAR; G8_WAIT_L(0); G8_MMA(0, 0, At, B0); G8_BAR; G8_SCHED;
            G8_LDB(B1, 0, 1); G8_STAGE(G8_SB(0, 0), b2_0, voffB);
            G8_BAR; G8_WAIT_L(0); G8_MMA(0, 1, At, B1); G8_BAR;
            G8_LDA(At, 0, 1); G8_STAGE(G8_SA(0, 0), a2_0, voffA);
            G8_BAR; G8_WAIT_L(0); G8_MMA(1, 0, At, B0); G8_BAR; G8_SCHED;
            G8_STAGE(G8_SB(0, 1), b2_1, voffB);
            G8_WAIT_V(6); G8_BAR; G8_MMA(1, 1, At, B1); G8_BAR;
            G8_LDB(B0, 1, 0); G8_SCHED; G8_LDA(At, 1, 0); G8_STAGE(G8_SA(0, 1), a2_1, voffA);
            G8_WAIT_L(8); G8_BAR; G8_WAIT_L(0); G8_MMA(0, 0, At, B0); G8_BAR; G8_SCHED;
            G8_LDB(B1, 1, 1); G8_STAGE(G8_SB(1, 0), b3_0, voffB);
            G8_BAR; G8_WAIT_L(0); G8_MMA(0, 1, At, B1); G8_BAR;
            G8_LDA(At, 1, 1); G8_STAGE(G8_SA(1, 0), a3_0, voffA);
            G8_BAR; G8_WAIT_L(0); G8_MMA(1, 0, At, B0); G8_BAR; G8_SCHED;
            G8_STAGE(G8_SB(1, 1), b3_1, voffB);
            G8_WAIT_V(6); G8_BAR; G8_MMA(1, 1, At, B1); G8_BAR;
            }
        }
        if constexpr (ALIGN_EPI) { if (wr == 0) G8_BAR; }
#pragma unroll
        for (int ai = 0; ai < 2; ++ai)
#pragma unroll
            for (int m = 0; m < 4; ++m) { const int row = cur.row0 + 128 * ai + 64 * wr + 16 * m + fr;
                if constexpr (DUAL) { const f32x4 g0 = acc[ai][0][m][0], g1 = acc[ai][0][m][1], u0 = acc[ai][1][m][0], u1 = acc[ai][1][m][1];
                    const float a[8] = {g0[0], g0[1], g0[2], g0[3], g1[0], g1[1], g1[2], g1[3]}, u[8] = {u0[0], u0[1], u0[2], u0[3], u1[0], u1[1], u1[2], u1[3]};
                    E.store2(row, cur.col0 + 32 * wc + 8 * fq, a, u); }
                else {
#pragma unroll
                    for (int bj = 0; bj < 2; ++bj) { const f32x4 v0 = acc[ai][bj][m][0], v1 = acc[ai][bj][m][1]; const float v[8] = {v0[0], v0[1], v0[2], v0[3], v1[0], v1[1], v1[2], v1[3]};
                        E.store(row, cur.col0 + 128 * bj + 32 * wc + 8 * fq, v); } } }
        if (!has_next) break;
#pragma unroll
        for (int a = 0; a < 2; ++a)
#pragma unroll
            for (int b = 0; b < 2; ++b)
#pragma unroll
                for (int m = 0; m < 4; ++m)
#pragma unroll
                    for (int n = 0; n < 2; ++n) acc[a][b][m][n] = (f32x4){0.f, 0.f, 0.f, 0.f};
        cur = nxt; cA0 = nA0; cA1 = nA1; cB0 = nB0; cB1 = nB1; ++ui;
        if constexpr (GATHER) {
#pragma unroll
            for (int i = 0; i < 2; ++i) { vA0[i] = (unsigned)nt0[i] * (unsigned)(lda * 2) + voffA[i]; vA1[i] = (unsigned)nt1[i] * (unsigned)(lda * 2) + voffA[i]; } }
        if constexpr (ALIGN_EPI) { if (wr == 1) G8_BAR; }
    }
    G8_WAIT_V(0);
    if constexpr (!ALIGN_EPI) { if (wr == 0) G8_BAR; }
    G8_BAR;
#undef G8_SA
#undef G8_SB
#undef G8_STAGE
#undef G8_STAGE2
#undef G8_LDA
#undef G8_LDB
#undef G8_MMA
#undef G8_WAIT_V
#undef G8_WAIT_L
#undef G8_BAR
#undef G8_SCHED
}
template <bool DUAL, class Epi, class Sched, bool GATHER = false>
DEVINL void gemm_phase_b3(LAS unsigned char* lds, const int K, const int lda, const int ldb, const Sched& S, const Epi& E) {
    const int tid = threadIdx.x, wid = __builtin_amdgcn_readfirstlane(tid >> 6), lane = tid & 63, wr = wid >> 2, wc = wid & 3, fr = lane & 15, fq = lane >> 4;
    const int nt = K / BK;
    unsigned voffA[2], voffB[2]; int rA[2];
#pragma unroll
    for (int i = 0; i < 2; ++i) { int R, C; stage_rc(tid * 16 + i * 8192, R, C); const int Rb = (R & ~31) + perm32(R & 31); rA[i] = R;
        voffA[i] = GATHER ? (unsigned)C * 2u : (unsigned)(R * lda + C) * 2u; voffB[i] = (unsigned)(Rb * ldb + C) * 2u; }
    unsigned vA0[2], vA1[2]; int nt0[2] = {0, 0}, nt1[2] = {0, 0};
    const size_t kstep = (size_t)(BK * 2);
    const unsigned ldsw = (unsigned)wid * 1024u;
    const int aoff = lds_byte(wr * 64 + fr, fq * 8), boff = lds_byte(wc * 32 + fr, fq * 8);
#define H3_SA(b, h) (((b) * 2 + (h)) * HTB)
#define H3_SB(s, h) (4 * HTB + ((s) * 2 + (h)) * HTB)
#define H3_STAGE(bufoff, gbase, v0_, v1_) do { \
        __builtin_amdgcn_global_load_lds((const unsigned*)((const char*)(gbase) + (v0_)), (LAS unsigned*)(lds + (bufoff) + ldsw), 16, 0, 0); \
        __builtin_amdgcn_global_load_lds((const unsigned*)((const char*)(gbase) + (v1_)), (LAS unsigned*)(lds + (bufoff) + ldsw + 8192), 16, 0, 0); } while (0)
#define H3_LDA(dst, b, h) do { _Pragma("unroll") for (int m = 0; m < 4; ++m) _Pragma("unroll") for (int k = 0; k < 2; ++k) dst[m][k] = *(const LAS bf16x8*)(lds + H3_SA(b, h) + aoff + m * 2048 + k * 1024); } while (0)
#define H3_LDB(dst, s, h) do { _Pragma("unroll") for (int n = 0; n < 2; ++n) _Pragma("unroll") for (int k = 0; k < 2; ++k) dst[n][k] = *(const LAS bf16x8*)(lds + H3_SB(s, h) + boff + n * 2048 + k * 1024); } while (0)
#define H3_MMA(ai, bj, At, Bt) do { __builtin_amdgcn_s_setprio(1); _Pragma("unroll") for (int m = 0; m < 4; ++m) _Pragma("unroll") for (int n = 0; n < 2; ++n) _Pragma("unroll") for (int k = 0; k < 2; ++k) \
        acc[ai][bj][m][n] = __builtin_amdgcn_mfma_f32_16x16x32_bf16(Bt[n][k], At[m][k], acc[ai][bj][m][n], 0, 0, 0); __builtin_amdgcn_s_setprio(0); } while (0)
#define H3_WAIT_V(n) asm volatile("s_waitcnt vmcnt(" #n ")" ::: "memory")
#define H3_WAIT_L(n) asm volatile("s_waitcnt lgkmcnt(" #n ")" ::: "memory")
#define H3_BAR __builtin_amdgcn_s_barrier()
#define H3_SCHED __builtin_amdgcn_sched_barrier(0)
    Unit cur, nxt; int ui = 0;
    if (!S.next(0, cur)) return;
    f32x4 acc[2][2][4][2];
#pragma unroll
    for (int a = 0; a < 2; ++a)
#pragma unroll
        for (int b = 0; b < 2; ++b)
#pragma unroll
            for (int m = 0; m < 4; ++m)
#pragma unroll
                for (int n = 0; n < 2; ++n) acc[a][b][m][n] = (f32x4){0.f, 0.f, 0.f, 0.f};
    bf16x8 At[4][2], B0[2][2], B1[2][2];
    const char *cA0 = cur.a0, *cA1 = cur.a1, *cB0 = cur.b0, *cB1 = cur.b1;
    if constexpr (GATHER) {
#pragma unroll
        for (int i = 0; i < 2; ++i) { vA0[i] = (unsigned)cur.sel[rA[i]] * (unsigned)(lda * 2) + voffA[i]; vA1[i] = (unsigned)cur.sel[128 + rA[i]] * (unsigned)(lda * 2) + voffA[i]; } }
    else { vA0[0] = vA1[0] = voffA[0]; vA0[1] = vA1[1] = voffA[1]; }
    H3_STAGE(H3_SB(0, 0), cB0, voffB[0], voffB[1]); H3_STAGE(H3_SB(0, 1), cB1, voffB[0], voffB[1]); H3_STAGE(H3_SA(0, 0), cA0, vA0[0], vA0[1]); H3_STAGE(H3_SA(0, 1), cA1, vA1[0], vA1[1]);
    if (wr == 1) H3_BAR;
    H3_WAIT_V(2); H3_BAR;
    H3_STAGE(H3_SB(1, 0), cB0 + kstep, voffB[0], voffB[1]); H3_STAGE(H3_SB(1, 1), cB1 + kstep, voffB[0], voffB[1]); H3_STAGE(H3_SA(1, 0), cA0 + kstep, vA0[0], vA0[1]);
    H3_STAGE(H3_SB(2, 0), cB0 + 2 * kstep, voffB[0], voffB[1]); H3_STAGE(H3_SB(2, 1), cB1 + 2 * kstep, voffB[0], voffB[1]);
    H3_WAIT_V(10); H3_BAR;
    int bs = 0;
    const char *ra0 = cA0 + 2 * kstep, *ra1 = cA1 + kstep, *rb0 = cB0 + 3 * kstep, *rb1 = cB1 + 3 * kstep;
    for (;;) {
        const bool has_next = S.next(ui + 1, nxt);
        const char *nA0 = has_next ? nxt.a0 : cA0, *nA1 = has_next ? nxt.a1 : cA1, *nB0 = has_next ? nxt.b0 : cB0, *nB1 = has_next ? nxt.b1 : cB1;
        if constexpr (GATHER) { if (has_next) {
#pragma unroll
            for (int i = 0; i < 2; ++i) { nt0[i] = nxt.sel[rA[i]]; nt1[i] = nxt.sel[128 + rA[i]]; } } }
        for (int t = 0; t < nt; t += 2) {
            const bool last = (t == nt - 2), prelast = (t == nt - 4);
            const int s0 = bs, s1 = (s0 == 2) ? 0 : s0 + 1;
            unsigned w0[2], w1[2];
#pragma unroll
            for (int i = 0; i < 2; ++i) { if constexpr (GATHER) { const bool nx_ = last && has_next; w0[i] = nx_ ? (unsigned)nt0[i] * (unsigned)(lda * 2) + voffA[i] : vA0[i]; w1[i] = nx_ ? (unsigned)nt1[i] * (unsigned)(lda * 2) + voffA[i] : vA1[i]; } else { w0[i] = voffA[i]; w1[i] = voffA[i]; } }
            H3_LDB(B0, s0, 0); H3_LDB(B1, s0, 1); H3_SCHED; H3_LDA(At, 0, 0); H3_STAGE(H3_SA(1, 1), ra1, vA1[0], vA1[1]); ra1 = last ? nA1 : ra1 + kstep;
            H3_WAIT_V(8); H3_WAIT_L(0); H3_BAR; H3_MMA(0, 0, At, B0); H3_MMA(0, 1, At, B1); H3_BAR; H3_SCHED;
            H3_LDA(At, 0, 1); H3_STAGE(H3_SA(0, 0), ra0, w0[0], w0[1]); ra0 += kstep;
            H3_STAGE(H3_SB(s0, 0), rb0, voffB[0], voffB[1]); H3_STAGE(H3_SB(s0, 1), rb1, voffB[0], voffB[1]); rb0 = prelast ? nB0 : rb0 + kstep; rb1 = prelast ? nB1 : rb1 + kstep;
            H3_WAIT_V(12); H3_WAIT_L(0); H3_BAR; H3_MMA(1, 0, At, B0); H3_MMA(1, 1, At, B1); H3_BAR; H3_SCHED;
            H3_LDB(B0, s1, 0); H3_LDB(B1, s1, 1); H3_SCHED; H3_LDA(At, 1, 0); H3_STAGE(H3_SA(0, 1), ra1, w1[0], w1[1]); ra1 += kstep;
            H3_WAIT_V(8); H3_WAIT_L(0); H3_BAR; H3_MMA(0, 0, At, B0); H3_MMA(0, 1, At, B1); H3_BAR; H3_SCHED;
            H3_LDA(At, 1, 1); H3_STAGE(H3_SA(1, 0), ra0, w0[0], w0[1]); ra0 = prelast ? nA0 : ra0 + kstep;
            H3_STAGE(H3_SB(s1, 0), rb0, voffB[0], voffB[1]); H3_STAGE(H3_SB(s1, 1), rb1, voffB[0], voffB[1]); rb0 += kstep; rb1 += kstep;
            H3_WAIT_V(12); H3_WAIT_L(0); H3_BAR; H3_MMA(1, 0, At, B0); H3_MMA(1, 1, At, B1); H3_BAR; H3_SCHED;
            bs = (s1 == 2) ? 0 : s1 + 1;
        }
        if (wr == 0) H3_BAR;
#pragma unroll
        for (int ai = 0; ai < 2; ++ai)
#pragma unroll
            for (int m = 0; m < 4; ++m) { const int row = cur.row0 + 128 * ai + 64 * wr + 16 * m + fr;
                if constexpr (DUAL) { const f32x4 g0 = acc[ai][0][m][0], g1 = acc[ai][0][m][1], u0 = acc[ai][1][m][0], u1 = acc[ai][1][m][1];
                    const float a[8] = {g0[0], g0[1], g0[2], g0[3], g1[0], g1[1], g1[2], g1[3]}, u[8] = {u0[0], u0[1], u0[2], u0[3], u1[0], u1[1], u1[2], u1[3]};
                    E.store2(row, cur.col0 + 32 * wc + 8 * fq, a, u); }
                else {
#pragma unroll
                    for (int bj = 0; bj < 2; ++bj) { const f32x4 v0 = acc[ai][bj][m][0], v1 = acc[ai][bj][m][1]; const float v[8] = {v0[0], v0[1], v0[2], v0[3], v1[0], v1[1], v1[2], v1[3]};
                        E.store(row, cur.col0 + 128 * bj + 32 * wc + 8 * fq, v); } } }
        if (!has_next) break;
#pragma unroll
        for (int a = 0; a < 2; ++a)
#pragma unroll
            for (int b = 0; b < 2; ++b)
#pragma unroll
                for (int m = 0; m < 4; ++m)
#pragma unroll
                    for (int n = 0; n < 2; ++n) acc[a][b][m][n] = (f32x4){0.f, 0.f, 0.f, 0.f};
        cur = nxt; cA0 = nA0; cA1 = nA1; cB0 = nB0; cB1 = nB1; ++ui;
        if constexpr (GATHER) {
#pragma unroll
            for (int i = 0; i < 2; ++i) { vA0[i] = (unsigned)nt0[i] * (unsigned)(lda * 2) + voffA[i]; vA1[i] = (unsigned)nt1[i] * (unsigned)(lda * 2) + voffA[i]; } }
        if (wr == 1) H3_BAR;
    }
    H3_WAIT_V(0);
    H3_BAR;
#undef H3_SA
#undef H3_SB
#undef H3_STAGE
#undef H3_LDA
#undef H3_LDB
#undef H3_MMA
#undef H3_WAIT_V
#undef H3_WAIT_L
#undef H3_BAR
#undef H3_SCHED
}
template <bool B3, bool DUAL, class Epi, class Sched, bool GATHER>
DEVINL void gemm_sel(LAS unsigned char* lds, const int K, const int lda, const int ldb, const Sched& S, const Epi& E) {
    if constexpr (B3) gemm_phase_b3<DUAL, Epi, Sched, GATHER>(lds, K, lda, ldb, S, E); else gemm_phase<DUAL, Epi, Sched, GATHER, EXP_BAUX>(lds, K, lda, ldb, S, E);
}
struct SchedPlain { TileOrder T; const bf16_t *A, *Bt; int lda, ldb;
    DEVINL bool next(int i, Unit& u) const { int pm, pn; if (!T.tile(i, pm, pn)) return false;
        u.a0 = (const char*)(A + (size_t)pm * 256 * lda); u.a1 = u.a0 + (size_t)128 * lda * 2; u.b0 = (const char*)(Bt + (size_t)pn * 256 * ldb); u.b1 = u.b0 + (size_t)128 * ldb * 2; u.sel = nullptr; u.row0 = pm * 256; u.col0 = pn * 256; return true; } };
struct SchedExpDual { TileOrder T; const bf16_t *A, *Wg, *Wu; const int* SEL;
    DEVINL bool next(int i, Unit& u) const { int pm, pn; if (!T.tile(i, pm, pn)) return false; const size_t wo = ((size_t)(pm >> 2) * FF + (size_t)pn * 128) * DM;
        u.a0 = (const char*)(A + (size_t)(pm & 3) * SEQ * DM); u.a1 = u.a0; u.sel = SEL + pm * 256; u.b0 = (const char*)(Wg + wo); u.b1 = (const char*)(Wu + wo); u.row0 = pm * 256; u.col0 = pn * 128; return true; } };
struct SchedExpDown { TileOrder T; const bf16_t *A, *Wd;
    DEVINL bool next(int i, Unit& u) const { int pm, pn; if (!T.tile(i, pm, pn)) return false; const size_t wo = ((size_t)(pm >> 2) * DM + (size_t)pn * 256) * FF;
        u.a0 = (const char*)(A + (size_t)pm * 256 * FF); u.a1 = u.a0 + (size_t)128 * FF * 2; u.b0 = (const char*)(Wd + wo); u.b1 = u.b0 + (size_t)128 * FF * 2; u.sel = nullptr; u.row0 = pm * 256; u.col0 = pn * 256; return true; } };
}

DEVINL void phase4(const Params& p, const int* pos_, const float* q_head_g_, const float* k_head_g_, int wave, int lane) {
    const int gw = blockIdx.x * NWAVES + wave, NGW = gridDim.x * NWAVES;
    const bf16_t* CQ = (const bf16_t*)(p.ws + WS_CQ); const bf16_t* CKV = (const bf16_t*)(p.ws + WS_CKV); const float* KPE = (const float*)(p.ws + WS_KPE);
    const bf16_t* QR = (const bf16_t*)(p.ws + WS_QRAW); const bf16_t* KVR = (const bf16_t*)(p.ws + WS_KVRAW);
    bf16_t* QF = (bf16_t*)(p.ws + WS_QF); bf16_t* KF = (bf16_t*)(p.ws + WS_KF); bf16_t* VF = (bf16_t*)(p.ws + WS_VF);
    typedef float f32x2 __attribute__((ext_vector_type(2)));
    const int l2 = 2 * lane, lr = l2 & 63, j0 = l2 & 31;
    const float if0 = 1.0f / powf(10000.0f, (float)(2 * j0) / 64.0f), if1 = 1.0f / powf(10000.0f, (float)(2 * j0 + 2) / 64.0f);
    const f32x2 gqn = *(const f32x2*)(q_head_g_ + l2), gkn = *(const f32x2*)(k_head_g_ + l2), gqr = *(const f32x2*)(q_head_g_ + 128 + lr), gkr = *(const f32x2*)(k_head_g_ + 128 + lr);
    const bool rl = lane < 32, second = (lane & 16) != 0;
    for (int row = gw; row < NTOK; row += NGW) {
        const int b = row >> 11, s = row & 2047;
        unsigned qn[8], qr[8], kn[8], vv[8];
#pragma unroll
        for (int h = 0; h < MH; ++h) { const bf16_t* q = QR + (size_t)row * 2048 + h * 256; const bf16_t* kv = KVR + (size_t)row * 2048 + h * 256;
            qn[h] = __builtin_nontemporal_load((const unsigned*)(q + l2)); qr[h] = __builtin_nontemporal_load((const unsigned*)(q + 128 + lr)); kn[h] = __builtin_nontemporal_load((const unsigned*)(kv + l2)); vv[h] = __builtin_nontemporal_load((const unsigned*)(kv + 128 + l2)); }
        const u32x4 cqv = __builtin_nontemporal_load((const u32x4*)(CQ + (size_t)row * QLORA + 8 * lane)); const u32x2 ckv = __builtin_nontemporal_load((const u32x2*)(CKV + (size_t)row * KVLORA + 4 * lane));
        const f32x2 kpe = *(const f32x2*)(KPE + (size_t)row * ROPE + lr);
        const float posf = (float)pos_[row];
        float sq = 0.f, skv = 0.f;
        { const unsigned w[4] = {cqv.x, cqv.y, cqv.z, cqv.w};
#pragma unroll
          for (int i = 0; i < 4; ++i) { const float a = bf2f(w[i] & 0xffffu), c = bf2f(w[i] >> 16); sq += a * a + c * c; }
          const float a0 = bf2f(ckv.x & 0xffffu), a1 = bf2f(ckv.x >> 16), a2 = bf2f(ckv.y & 0xffffu), a3 = bf2f(ckv.y >> 16); skv = a0 * a0 + a1 * a1 + a2 * a2 + a3 * a3; }
        const float rq = __builtin_amdgcn_rsqf(wave_sum(sq) * (1.f / QLORA) + EPS), rkv = __builtin_amdgcn_rsqf(wave_sum(skv) * (1.f / KVLORA) + EPS);
        const float rv0 = __builtin_amdgcn_fractf(posf * if0 * 0.15915494309189535f), rv1 = __builtin_amdgcn_fractf(posf * if1 * 0.15915494309189535f);
        const float sn0 = __builtin_amdgcn_sinf(rv0), cs0 = __builtin_amdgcn_cosf(rv0), sn1 = __builtin_amdgcn_sinf(rv1), cs1 = __builtin_amdgcn_cosf(rv1);
        const float kp0 = rl ? kpe.x : 0.f, kp1 = rl ? kpe.y : 0.f;
#pragma unroll
        for (int h = 0; h < MH; ++h) {
            { const float v0 = rq * bf2f(qn[h] & 0xffffu), v1 = rq * bf2f(qn[h] >> 16), v2 = rl ? rq * bf2f(qr[h] & 0xffffu) : 0.f, v3 = rl ? rq * bf2f(qr[h] >> 16) : 0.f;
              const float inv = __builtin_amdgcn_rsqf(wave_sum(v0 * v0 + v1 * v1 + v2 * v2 + v3 * v3) * (1.f / QK) + EPS);
              const float n2 = v2 * inv * gqr.x, n3 = v3 * inv * gqr.y, p2 = get_xor16(n2, second), p3 = get_xor16(n3, second);
              const float r2 = second ? (n2 * cs0 + p2 * sn0) : (n2 * cs0 - p2 * sn0), r3 = second ? (n3 * cs1 + p3 * sn1) : (n3 * cs1 - p3 * sn1);
              bf16_t* o = QF + ((size_t)(b * MH + h) * SEQ + s) * QK; *(unsigned*)(o + l2) = pk2(v0 * inv * gqn.x, v1 * inv * gqn.y); if (rl) *(unsigned*)(o + 128 + lr) = pk2(r2, r3); }
            { const float v0 = rkv * bf2f(kn[h] & 0xffffu), v1 = rkv * bf2f(kn[h] >> 16);
              const float inv = __builtin_amdgcn_rsqf(wave_sum(v0 * v0 + v1 * v1 + kp0 * kp0 + kp1 * kp1) * (1.f / QK) + EPS);
              const float n2 = kp0 * inv * gkr.x, n3 = kp1 * inv * gkr.y, p2 = get_xor16(n2, second), p3 = get_xor16(n3, second);
              const float r2 = second ? (n2 * cs0 + p2 * sn0) : (n2 * cs0 - p2 * sn0), r3 = second ? (n3 * cs1 + p3 * sn1) : (n3 * cs1 - p3 * sn1);
              bf16_t* o = KF + ((size_t)(b * MH + h) * SEQ + s) * QK; *(unsigned*)(o + l2) = pk2(v0 * inv * gkn.x, v1 * inv * gkn.y); if (rl) *(unsigned*)(o + 128 + lr) = pk2(r2, r3);
              *(unsigned*)(VF + ((size_t)(b * MH + h) * SEQ + s) * MV + l2) = pk2(rkv * bf2f(vv[h] & 0xffffu), rkv * bf2f(vv[h] >> 16)); }
        }
    }
}

DEVINL void attn_naive(const Params& p, LAS unsigned char* lds, int wave, int lane) {
    const bf16_t* QF = (const bf16_t*)(p.ws + WS_QF); const bf16_t* KF = (const bf16_t*)(p.ws + WS_KF); const bf16_t* VF = (const bf16_t*)(p.ws + WS_VF); bf16_t* MIX = (bf16_t*)(p.ws + WS_MIXED);
    LAS float* ql = (LAS float*)(lds + wave * 9216);
    LAS float* pl = ql + 192;
    const int gw = blockIdx.x * NWAVES + wave, NGW = gridDim.x * NWAVES;
    const float scale = 0.07216878364870322f;
    for (int qi = gw; qi < NB * MH * SEQ; qi += NGW) {
        const int bh = qi >> 11, s = qi & 2047, b = bh >> 3, h = bh & 7;
        const bf16_t* q = QF + (size_t)qi * QK; ql[lane] = bf2f(q[lane]); ql[64 + lane] = bf2f(q[64 + lane]); ql[128 + lane] = bf2f(q[128 + lane]);
        LDS_WAIT();
        float mx = -1e30f;
        for (int i = 0; i < 32; ++i) { const bf16_t* k = KF + ((size_t)bh * SEQ + lane + 64 * i) * QK; float a = 0.f;
#pragma unroll
            for (int d = 0; d < QK; d += 8) { float kf[8]; ld8f(k + d, kf);
#pragma unroll
                for (int e = 0; e < 8; ++e) a += kf[e] * ql[d + e]; }
            a *= scale; pl[lane + 64 * i] = a; mx = fmaxf(mx, a); }
#pragma unroll
        for (int o = 1; o < 64; o <<= 1) mx = fmaxf(mx, __shfl_xor(mx, o));
        LDS_WAIT();
        float sum = 0.f;
        for (int i = 0; i < 32; ++i) { const float e = __expf(pl[lane + 64 * i] - mx); sum += e; pl[lane + 64 * i] = e; }
        sum = wave_sum(sum); LDS_WAIT();
        float o0 = 0.f, o1 = 0.f; const bf16_t* v = VF + (size_t)bh * SEQ * MV + 2 * lane;
        for (int kk = 0; kk < SEQ; ++kk) { const unsigned w = *(const unsigned*)(v + (size_t)kk * MV); const float pr = pl[kk]; o0 += pr * bf2f(w & 0xffffu); o1 += pr * bf2f(w >> 16); }
        const float il = 1.f / sum;
        *(unsigned*)(MIX + (size_t)(b * SEQ + s) * DM + HW + h * MV + 2 * lane) = pk2(o0 * il, o1 * il);
        LDS_WAIT();
    }
}

namespace at {
using f32x16 = __attribute__((ext_vector_type(16))) float;
using s16x4 = __attribute__((ext_vector_type(4))) short;
constexpr float SCALE = 0.07216878364870322f;
constexpr float THR = 8.f;
constexpr int KT_BYTES = 64 * 400, VT_BYTES = 64 * MV * 2;
#define AT_KSWZ(row, colB) ((row) * 400 + (colB))
#define AT_SBAR() __builtin_amdgcn_sched_barrier(0)
DEVINL int crow(int r, int hi) { return (r & 3) + 8 * (r >> 2) + 4 * hi; }
DEVINL unsigned cvtpk(float lo, float hi) { unsigned r; asm volatile("v_cvt_pk_bf16_f32 %0, %1, %2" : "=v"(r) : "v"(lo), "v"(hi)); return r; }
DEVINL void partialSM(f32x16& p0, f32x16& p1, float& m_reg, float& mn, float& alpha) {
    constexpr float C = SCALE * 1.4426950408889634f;
    float pmax = p0[0];
#pragma unroll
    for (int r = 1; r < 16; ++r) pmax = fmaxf(pmax, p0[r]);
#pragma unroll
    for (int r = 0; r < 16; ++r) pmax = fmaxf(pmax, p1[r]);
    { auto rr = __builtin_amdgcn_permlane32_swap(__float_as_uint(pmax), __float_as_uint(pmax), false, false); pmax = fmaxf(__uint_as_float(rr[0]), __uint_as_float(rr[1])); }
    if (__builtin_expect(__all(pmax - m_reg <= THR / SCALE), 1)) { mn = m_reg; alpha = 1.f; }
    else { mn = fmaxf(m_reg, pmax); alpha = __builtin_amdgcn_exp2f((m_reg - mn) * C); m_reg = mn; }
    const float mnC = -mn * C;
#pragma unroll
    for (int r = 0; r < 16; ++r) p0[r] = __builtin_amdgcn_exp2f(fmaf(p0[r], C, mnC));
#pragma unroll
    for (int r = 0; r < 16; ++r) p1[r] = __builtin_amdgcn_exp2f(fmaf(p1[r], C, mnC));
}
DEVINL void finishSM(f32x16& p0, f32x16& p1, float alpha, float& l_reg, bf16x8& pa0, bf16x8& pa1, bf16x8& pa2, bf16x8& pa3) {
    float ps = 0;
#pragma unroll
    for (int r = 0; r < 16; ++r) ps += p0[r];
#pragma unroll
    for (int r = 0; r < 16; ++r) ps += p1[r];
    { auto rr = __builtin_amdgcn_permlane32_swap(__float_as_uint(ps), __float_as_uint(ps), false, false); ps = __uint_as_float(rr[0]) + __uint_as_float(rr[1]); }
    l_reg = l_reg * alpha + ps;
#define AT_PK4(P, BASE, OUT) do { unsigned a0 = cvtpk(P[BASE + 0], P[BASE + 1]), a1 = cvtpk(P[BASE + 2], P[BASE + 3]);   \
    unsigned b0 = cvtpk(P[BASE + 4], P[BASE + 5]), b1 = cvtpk(P[BASE + 6], P[BASE + 7]);                              \
    auto r0 = __builtin_amdgcn_permlane32_swap(a0, b0, false, false); auto r1 = __builtin_amdgcn_permlane32_swap(a1, b1, false, false); \
    u32x4 w = {r0[0], r1[0], r0[1], r1[1]}; OUT = *reinterpret_cast<bf16x8*>(&w); } while (0)
    AT_PK4(p0, 0, pa0); AT_PK4(p0, 8, pa1); AT_PK4(p1, 0, pa2); AT_PK4(p1, 8, pa3);
#undef AT_PK4
}
DEVINL void qkt(f32x16& p0, f32x16& p1, const LAS char* Ks, const bf16x8* qr, int r32, int hi) {
    p0 = f32x16{}; p1 = f32x16{};
#pragma unroll
    for (int d0 = 0; d0 < 12; ++d0) { const int cb = (d0 * 16 + hi * 8) * 2;
        const bf16x8 b0 = *reinterpret_cast<const LAS bf16x8*>(Ks + AT_KSWZ(r32, cb));
        const bf16x8 b1 = *reinterpret_cast<const LAS bf16x8*>(Ks + AT_KSWZ(32 + r32, cb));
        p0 = __builtin_amdgcn_mfma_f32_32x32x16_bf16(b0, qr[d0], p0, 0, 0, 0);
        p1 = __builtin_amdgcn_mfma_f32_32x32x16_bf16(b1, qr[d0], p1, 0, 0, 0); }
}
DEVINL int v_st(int k, int c) { const int kk = (k & ~0xC) | ((k & 4) << 1) | ((k & 8) >> 1); return ((kk >> 3) * 4 + (c >> 5)) * 512 + ((kk & 7) * 32 + (c & 31)) * 2; }
DEVINL int v_rd_base(int lane) { return ((lane & 3) << 3) | (((lane >> 2) & 3) << 6) | (((lane >> 4) & 1) << 5) | (((lane >> 5) & 1) << 8); }
constexpr int v_rd_off(int d0, int ks, int half) { return d0 * 512 + ks * 4096 + half * 2048; }
template <int OFF> DEVINL s16x4 tr_read(int vb) { s16x4 r; asm volatile("ds_read_b64_tr_b16 %0, %1 offset:%2" : "=&v"(r) : "v"(vb), "i"(OFF) : "memory"); return r; }
template <int D0> DEVINL void pv_one(f32x16& od, int vb, bf16x8 pa0, bf16x8 pa1, bf16x8 pa2, bf16x8 pa3) {
    const s16x4 l0 = tr_read<v_rd_off(D0, 0, 0)>(vb), h0 = tr_read<v_rd_off(D0, 0, 1)>(vb), l1 = tr_read<v_rd_off(D0, 1, 0)>(vb), h1 = tr_read<v_rd_off(D0, 1, 1)>(vb);
    const s16x4 l2 = tr_read<v_rd_off(D0, 2, 0)>(vb), h2 = tr_read<v_rd_off(D0, 2, 1)>(vb), l3 = tr_read<v_rd_off(D0, 3, 0)>(vb), h3 = tr_read<v_rd_off(D0, 3, 1)>(vb);
    asm volatile("s_waitcnt lgkmcnt(0)" ::: "memory"); AT_SBAR();
#define AT_PK(L, H) (bf16x8){L[0], L[1], L[2], L[3], H[0], H[1], H[2], H[3]}
    od = __builtin_amdgcn_mfma_f32_32x32x16_bf16(pa0, AT_PK(l0, h0), od, 0, 0, 0);
    od = __builtin_amdgcn_mfma_f32_32x32x16_bf16(pa1, AT_PK(l1, h1), od, 0, 0, 0);
    od = __builtin_amdgcn_mfma_f32_32x32x16_bf16(pa2, AT_PK(l2, h2), od, 0, 0, 0);
    od = __builtin_amdgcn_mfma_f32_32x32x16_bf16(pa3, AT_PK(l3, h3), od, 0, 0, 0);
#undef AT_PK
}
template <bool FIXM>
DEVINL void attn_unit(const bf16_t* Qb, const bf16_t* Kh, const bf16_t* Vh, bf16_t* Ob, LAS char* lds, const float mfix) {
    const int tid = threadIdx.x, wid = tid >> 6, lane = tid & 63, r32 = lane & 31, hi = lane >> 5;
    LAS char* K_lds = lds; LAS char* V_lds = lds + KT_BYTES; LAS float* wsf = (LAS float*)(lds + KT_BYTES + VT_BYTES) + wid * 64; LAS float* li_l = wsf; LAS float* al_l = wsf + 32;
    float m_reg = -1e30f, l_reg = 0.f; f32x16 o[4] = {}; bf16x8 qr[12];
    if (ATT_PRIO) { if (wid < 4) __builtin_amdgcn_s_setprio(3); else __builtin_amdgcn_s_setprio(0); }
    { unsigned qo_ = (unsigned)((wid * 32 + r32) * QK + hi * 8) * 2u; asm volatile("" : "+v"(qo_));
#pragma unroll
      for (int d0 = 0; d0 < 12; ++d0) qr[d0] = *reinterpret_cast<const bf16x8*>((const char*)Qb + (qo_ + 32u * d0)); }
    const int vb0 = (int)(uintptr_t)V_lds + v_rd_base(lane);
    bf16x8 ks[3], vs[2];
#define AT_LOAD(k0) do { unsigned lo_ = (unsigned)tid * 16u; asm volatile("" : "+v"(lo_)); const char* kb_ = (const char*)(Kh + (size_t)(k0) * QK); const char* vb_ = (const char*)(Vh + (size_t)(k0) * MV); \
                         _Pragma("unroll") for (int i = 0; i < 3; ++i) ks[i] = *reinterpret_cast<const bf16x8*>(kb_ + (lo_ + 8192u * i)); \
                         _Pragma("unroll") for (int i = 0; i < 2; ++i) { const unsigned c = (lo_ >> 4) + 512u * i, kk = ((c >> 7) & 7) * 8 + ((c >> 2) & 7), key = (kk & ~0xCu) | ((kk & 4) << 1) | ((kk & 8) >> 1), ch = ((c >> 5) & 3) * 4 + (c & 3); \
                             vs[i] = *reinterpret_cast<const bf16x8*>(vb_ + (key * MV + ch * 8) * 2u); } } while (0)
    AT_LOAD(0);
    constexpr int NT = SEQ / 64;
    for (int j = 0; j < NT; ++j) {
        __syncthreads();
        { int t_ = tid; asm volatile("" : "+v"(t_));
#pragma unroll
          for (int i = 0; i < 3; ++i) { const int c = t_ + 512 * i, key = c / 24, ch = c % 24; *reinterpret_cast<LAS bf16x8*>(K_lds + AT_KSWZ(key, ch * 16)) = ks[i]; }
#pragma unroll
          for (int i = 0; i < 2; ++i) *reinterpret_cast<LAS bf16x8*>(V_lds + 16 * (t_ + 512 * i)) = vs[i]; }
        __syncthreads();
        if (j + 1 < NT) AT_LOAD((j + 1) * 64);
        f32x16 p0, p1; float mn, alpha; bf16x8 pa0, pa1, pa2, pa3;
        qkt(p0, p1, K_lds, qr, r32, hi);
        if constexpr (FIXM) { constexpr float C = SCALE * 1.4426950408889634f; const float mnC = -mfix * C; alpha = 1.f; mn = mfix;
#pragma unroll
            for (int r = 0; r < 16; ++r) p0[r] = __builtin_amdgcn_exp2f(fmaf(p0[r], C, mnC));
#pragma unroll
            for (int r = 0; r < 16; ++r) p1[r] = __builtin_amdgcn_exp2f(fmaf(p1[r], C, mnC)); }
        else {
        partialSM(p0, p1, m_reg, mn, alpha);
        if (__any(alpha < 1.f)) { if (hi == 0) al_l[r32] = alpha; asm volatile("s_waitcnt lgkmcnt(0)" ::: "memory");
#pragma unroll
            for (int d = 0; d < 4; ++d)
#pragma unroll
                for (int r = 0; r < 16; ++r) o[d][r] *= al_l[crow(r, hi)]; } }
        finishSM(p0, p1, alpha, l_reg, pa0, pa1, pa2, pa3);
        pv_one<0>(o[0], vb0, pa0, pa1, pa2, pa3); pv_one<1>(o[1], vb0, pa0, pa1, pa2, pa3); pv_one<2>(o[2], vb0, pa0, pa1, pa2, pa3); pv_one<3>(o[3], vb0, pa0, pa1, pa2, pa3);
    }
#undef AT_LOAD
    { int r_ = lane & 31; asm volatile("" : "+v"(r_)); if (hi == 0) li_l[r_] = l_reg; } asm volatile("s_waitcnt lgkmcnt(0)" ::: "memory");
    bf16_t* Ow = Ob + (size_t)(wid * 32) * DM;
#pragma unroll
    for (int r = 0; r < 16; ++r) { const int orow = crow(r, hi); const float rl = __builtin_amdgcn_rcpf(li_l[orow]);
#pragma unroll
        for (int d0 = 0; d0 < 4; ++d0) Ow[(size_t)orow * DM + d0 * 32 + r32] = (bf16_t)f2bf(o[d0][r] * rl); }
    if (ATT_PRIO) __builtin_amdgcn_s_setprio(0);
    __syncthreads();
}
DEVINL void attn_phase(const Params& p, LAS unsigned char* lds) {
    const bf16_t* QF = (const bf16_t*)(p.ws + WS_QF); const bf16_t* KF = (const bf16_t*)(p.ws + WS_KF); const bf16_t* VF = (const bf16_t*)(p.ws + WS_VF); bf16_t* MIX = (bf16_t*)(p.ws + WS_MIXED);
    const int G = gridDim.x, first = G >= 256 ? 128 : 0, nfree = G - first;
    if ((int)blockIdx.x < first) return;
    float mfix; bool fixm;
    { const float* qg = (const float*)kaptr(KAOFF(q_head_g)); const float* kg = (const float*)kaptr(KAOFF(k_head_g)); const int l = threadIdx.x & 63;
      float a = fmaxf(fmaxf(fabsf(qg[l]), fabsf(qg[l + 64])), fabsf(qg[l + 128])), c = fmaxf(fmaxf(fabsf(kg[l]), fabsf(kg[l + 64])), fabsf(kg[l + 128]));
#pragma unroll
      for (int o = 1; o < 64; o <<= 1) { a = fmaxf(a, __shfl_xor(a, o)); c = fmaxf(c, __shfl_xor(c, o)); }
      mfix = 1.02f * (float)QK * a * c;
      fixm = __builtin_amdgcn_readfirstlane((2.f * mfix * SCALE * 1.4426950408889634f < 96.f) ? 1 : 0) != 0; }
#define AT_UNITS(FIXM_, MF_) for (int u = blockIdx.x - first, r = 0; u < NB * MH * (SEQ / 256); u += nfree, ++r) { \
        int bh = u >> 3, qb = u & 7; \
        if (nfree == 128) { const int w = blockIdx.x - first, s = w >> 3; bh = r * 16 + (w & 7) * 2 + (s >> 3); qb = s & 7; }     \
        const int b = bh >> 3, h = bh & 7; \
        attn_unit<FIXM_>(QF + ((size_t)bh * SEQ + qb * 256) * QK, KF + (size_t)bh * SEQ * QK, VF + (size_t)bh * SEQ * MV, MIX + ((size_t)b * SEQ + qb * 256) * DM + HW + h * MV, (LAS char*)lds, MF_); }
    if (fixm) { AT_UNITS(true, mfix) } else { AT_UNITS(false, 0.f) }
#undef AT_UNITS
}
}

DEVINL void hgrn_naive(const Params& p, LAS unsigned char* lds, int tid) {
    const bf16_t* HQ = (const bf16_t*)(p.ws + WS_HQ); const bf16_t* HI = (const bf16_t*)(p.ws + WS_HI);
    const int sub = tid >> 8, t2 = tid & 255, v = t2 & 127, kh = t2 >> 7; constexpr int TC = 16;
    LAS float* fl = (LAS float*)lds + sub * (4 * TC * 128); LAS float* qlds = fl + TC * 128; LAS float* po = qlds + TC * 128;
    for (int cg2 = blockIdx.x; cg2 < 32; cg2 += gridDim.x) {
        const int chain = cg2 * 2 + sub, b = chain >> 4, dir = (chain >> 3) & 1, h = chain & 7;
        const float* G = (const float*)(p.ws + (dir ? WS_GB : WS_GF)); bf16_t* O = (bf16_t*)(p.ws + (dir ? WS_OB : WS_OF));
        float S[64];
#pragma unroll
        for (int k = 0; k < 64; ++k) S[k] = 0.f;
        for (int c0 = 0; c0 < SEQ; c0 += TC) {
            __syncthreads();
            for (int i = t2; i < TC * 128; i += 256) { const int tt = i >> 7, k = i & 127; const int t = dir ? (SEQ - 1 - (c0 + tt)) : (c0 + tt); const size_t row = (size_t)b * SEQ + t;
                fl[i] = __builtin_amdgcn_exp2f(G[row * HW + h * 128 + k]); qlds[i] = bf2f(HQ[row * HW + h * 128 + k]); }
            __syncthreads();
            for (int tt = 0; tt < TC; ++tt) { const int t = dir ? (SEQ - 1 - (c0 + tt)) : (c0 + tt); const size_t row = (size_t)b * SEQ + t;
                const float vv = bf2f(HI[row * HW + h * 128 + v]); float o = 0.f;
#pragma unroll
                for (int k = 0; k < 64; ++k) { const float f = fl[tt * 128 + kh * 64 + k]; S[k] = f * S[k] + (1.f - f) * vv; o += S[k] * qlds[tt * 128 + kh * 64 + k]; }
                po[(tt * 2 + kh) * 128 + v] = o; }
            __syncthreads();
            for (int i = t2; i < TC * 128; i += 256) { const int tt = i >> 7, vv2 = i & 127; const int t = dir ? (SEQ - 1 - (c0 + tt)) : (c0 + tt); const size_t row = (size_t)b * SEQ + t;
                O[row * HW + h * 128 + vv2] = (bf16_t)f2bf(po[(tt * 2) * 128 + vv2] + po[(tt * 2 + 1) * 128 + vv2]); }
        }
    }
}

namespace hg {
using at::f32x16; using at::s16x4;
constexpr int QIMG = 0, KIMG = 17408, QHIMG = 34816, KTIMG = 52224, VIMG = 70656, SIMG = 87040, QOFF = 121856, EBL = 125952;
constexpr float LOG2E = 1.4426950408889634f;
#define HG_SWZ256(row, colB) ((row) * 272 + (colB))
#define HG_SWZ128(row, colB) ((row) * 144 + (colB))
#define HG_BAR() asm volatile("s_waitcnt lgkmcnt(0)\n\ts_barrier" ::: "memory")
template <bool STATE>
DEVINL void hgrn_loop(const Params& p, LAS char* lds, int chain, int wid, int lane) {
    const int b = chain >> 4, dir = (chain >> 3) & 1, h = chain & 7;
    const float* G = (const float*)(p.ws + (dir ? WS_GB : WS_GF)); bf16_t* O = (bf16_t*)(p.ws + (dir ? WS_OB : WS_OF));
    const bf16_t* HQ = (const bf16_t*)(p.ws + WS_HQ); const bf16_t* HI = (const bf16_t*)(p.ws + WS_HI);
    const int tid = threadIdx.x, r32 = lane & 31, hi = lane >> 5;
    const int tq = wid, k2 = 2 * lane, colbase = h * 128, vt = wid & 3;
    LAS float* qoff = (LAS float*)(lds + QOFF); LAS float* ebl = (LAS float*)(lds + EBL);
    typedef float f32x2 __attribute__((ext_vector_type(2)));
    f32x16 st[4] = {};
    f32x2 gl[8]; unsigned ql[8]; bf16x8 vs[2];
    f32x2 gl2[8]; unsigned ql2[8]; bf16x8 vs2[2];
#define HG_LOAD(n_, gl, ql, vs) do { int nn_ = __builtin_amdgcn_readfirstlane(n_); asm volatile("" : "+s"(nn_)); _Pragma("unroll") for (int i = 0; i < 8; ++i) { const int tau = 8 * tq + i, t = dir ? (SEQ - 1 - (64 * nn_ + tau)) : (64 * nn_ + tau); const size_t ro = ((size_t)b * SEQ + t) * HW + colbase + k2; gl[i] = __builtin_nontemporal_load(reinterpret_cast<const f32x2*>(G + ro)); ql[i] = __builtin_nontemporal_load(reinterpret_cast<const unsigned*>(HQ + ro)); } \
        _Pragma("unroll") for (int i2 = 0; i2 < 2; ++i2) { const int c = tid + 512 * i2, tau = c >> 4, ch = c & 15, t = dir ? (SEQ - 1 - (64 * nn_ + tau)) : (64 * nn_ + tau); vs[i2] = __builtin_nontemporal_load(reinterpret_cast<const bf16x8*>(HI + ((size_t)b * SEQ + t) * HW + colbase + ch * 8)); } } while (0)
    HG_LOAD(0, gl, ql, vs); HG_LOAD(1, gl2, ql2, vs2);
    for (int n = 0; n < SEQ / 64; ++n) {
        f32x2 pre[8]; f32x2 run = {0.f, 0.f};
#pragma unroll
        for (int i = 0; i < 8; ++i) { run += gl[i]; pre[i] = run; }
        *reinterpret_cast<LAS f32x2*>(qoff + tq * 128 + k2) = run;
        __builtin_amdgcn_sched_barrier(0); HG_BAR(); __builtin_amdgcn_sched_barrier(0);
        f32x2 off = {0.f, 0.f}, ref2 = {0.f, 0.f}, bl2 = {0.f, 0.f};
#pragma unroll
        for (int j = 0; j < 8; ++j) { const f32x2 tj = *reinterpret_cast<const LAS f32x2*>(qoff + j * 128 + k2); if (j < tq) off += tj; if (j < 4) ref2 += tj; bl2 += tj; }
        const f32x2 eref = {__builtin_amdgcn_exp2f(ref2.x), __builtin_amdgcn_exp2f(ref2.y)}, ebr = {__builtin_amdgcn_exp2f(bl2.x - ref2.x), __builtin_amdgcn_exp2f(bl2.y - ref2.y)};
        if (tq == 0) *reinterpret_cast<LAS f32x2*>(ebl + k2) = (f32x2){__builtin_amdgcn_exp2f(bl2.x), __builtin_amdgcn_exp2f(bl2.y)};
        unsigned kpa[8], kpb[8];
#pragma unroll
        for (int i = 0; i < 8; ++i) { const int tau = 8 * tq + i; const f32x2 b2 = pre[i] + off, d = b2 - ref2;
            const float fa = __builtin_amdgcn_exp2f(gl[i].x), fb = __builtin_amdgcn_exp2f(gl[i].y), kka = 1.f - fa, kkb = 1.f - fb;
            const float e1a = __builtin_amdgcn_exp2f(fminf(d.x, 120.f)), e1b = __builtin_amdgcn_exp2f(fminf(d.y, 120.f)), ia = __builtin_amdgcn_exp2f(fminf(-d.x, 120.f)), ib = __builtin_amdgcn_exp2f(fminf(-d.y, 120.f));
            const float qa = bf2f(ql[i] & 0xffffu), qb = bf2f(ql[i] >> 16), qta = qa * e1a, qtb = qb * e1b, kta = kka * ia, ktb = kkb * ib;
            const int o = HG_SWZ256(tau, 2 * k2);
            *reinterpret_cast<LAS unsigned*>(lds + QIMG + o) = pk2(qta, qtb); *reinterpret_cast<LAS unsigned*>(lds + KIMG + o) = pk2(kta, ktb);
            *reinterpret_cast<LAS unsigned*>(lds + QHIMG + o) = pk2(qta * eref.x, qtb * eref.y); kpa[i] = __float_as_uint(kta * ebr.x); kpb[i] = __float_as_uint(ktb * ebr.y); }
        {
#define HG_P(a, i) pk2(__uint_as_float(a[i]), __uint_as_float(a[i + 1]))
          const u32x4 wa = {HG_P(kpa, 0), HG_P(kpa, 2), HG_P(kpa, 4), HG_P(kpa, 6)}, wb = {HG_P(kpb, 0), HG_P(kpb, 2), HG_P(kpb, 4), HG_P(kpb, 6)};
#undef HG_P
          *reinterpret_cast<LAS u32x4*>(lds + KTIMG + HG_SWZ128(k2, 16 * tq)) = wa; *reinterpret_cast<LAS u32x4*>(lds + KTIMG + HG_SWZ128(k2 + 1, 16 * tq)) = wb; }
#pragma unroll
        for (int i2 = 0; i2 < 2; ++i2) { const int c = tid + 512 * i2, tau = c >> 4, ch = c & 15; *reinterpret_cast<LAS bf16x8*>(lds + VIMG + at::v_st(tau, ch * 8)) = vs[i2]; }
        if constexpr (STATE) {
#pragma unroll
            for (int kt = 0; kt < 4; ++kt)
#pragma unroll
                for (int g = 0; g < 4; ++g) { const int k0 = 32 * kt + 8 * g + 4 * hi, v = 32 * vt + r32; u32x2 w; w.x = pk2(st[kt][4 * g], st[kt][4 * g + 1]); w.y = pk2(st[kt][4 * g + 2], st[kt][4 * g + 3]);
                    *reinterpret_cast<LAS u32x2*>(lds + SIMG + HG_SWZ256(v, 2 * k0)) = w; }
        }
        __builtin_amdgcn_sched_barrier(0); HG_BAR(); __builtin_amdgcn_sched_barrier(0);
#pragma unroll
        for (int i = 0; i < 8; ++i) { gl[i] = gl2[i]; ql[i] = ql2[i]; }
        vs[0] = vs2[0]; vs[1] = vs2[1];
        if (n + 2 < SEQ / 64) HG_LOAD(n + 2, gl2, ql2, vs2);
        __builtin_amdgcn_sched_barrier(0);
        if constexpr (!STATE) {
            const int tb = wid & 1, dh = wid >> 1, tl = 32 * tb + r32;
            f32x16 p0 = {}, p1 = {};
#pragma unroll
            for (int d0 = 0; d0 < 8; ++d0) { const int cb = (d0 * 16 + hi * 8) * 2;
                const bf16x8 qf = *reinterpret_cast<const LAS bf16x8*>(lds + QIMG + HG_SWZ256(tl, cb));
                const bf16x8 b0 = *reinterpret_cast<const LAS bf16x8*>(lds + KIMG + HG_SWZ256(r32, cb)), b1 = *reinterpret_cast<const LAS bf16x8*>(lds + KIMG + HG_SWZ256(32 + r32, cb));
                p0 = __builtin_amdgcn_mfma_f32_32x32x16_bf16(b0, qf, p0, 0, 0, 0); p1 = __builtin_amdgcn_mfma_f32_32x32x16_bf16(b1, qf, p1, 0, 0, 0); }
#pragma unroll
            for (int r = 0; r < 16; ++r) { const int sk = at::crow(r, hi); p0[r] = (sk <= tl) ? p0[r] : 0.f; p1[r] = (sk + 32 <= tl) ? p1[r] : 0.f; }
            __builtin_amdgcn_sched_barrier(0);
            bf16x8 pa0, pa1, pa2, pa3;
#define HG_PK4(P, BASE, OUT) do { unsigned a0 = at::cvtpk(P[BASE + 0], P[BASE + 1]), a1 = at::cvtpk(P[BASE + 2], P[BASE + 3]), b0_ = at::cvtpk(P[BASE + 4], P[BASE + 5]), b1_ = at::cvtpk(P[BASE + 6], P[BASE + 7]); \
    auto r0 = __builtin_amdgcn_permlane32_swap(a0, b0_, false, false); auto r1 = __builtin_amdgcn_permlane32_swap(a1, b1_, false, false); u32x4 w = {r0[0], r1[0], r0[1], r1[1]}; OUT = *reinterpret_cast<bf16x8*>(&w); } while (0)
            HG_PK4(p0, 0, pa0); HG_PK4(p0, 8, pa1); HG_PK4(p1, 0, pa2); HG_PK4(p1, 8, pa3);
#undef HG_PK4
            __builtin_amdgcn_sched_barrier(0);
            f32x16 o0 = {}, o1 = {};
            const int vb = (int)(uintptr_t)(lds + VIMG) + at::v_rd_base(lane) + dh * 1024;
            at::pv_one<0>(o0, vb, pa0, pa1, pa2, pa3); at::pv_one<1>(o1, vb, pa0, pa1, pa2, pa3);
#pragma unroll
            for (int s8 = 0; s8 < 8; ++s8) { const int cb = (s8 * 16 + hi * 8) * 2;
                const bf16x8 a = *reinterpret_cast<const LAS bf16x8*>(lds + QHIMG + HG_SWZ256(tl, cb));
                const bf16x8 s0 = *reinterpret_cast<const LAS bf16x8*>(lds + SIMG + HG_SWZ256(64 * dh + r32, cb)), s1 = *reinterpret_cast<const LAS bf16x8*>(lds + SIMG + HG_SWZ256(64 * dh + 32 + r32, cb));
                o0 = __builtin_amdgcn_mfma_f32_32x32x16_bf16(a, s0, o0, 0, 0, 0); o1 = __builtin_amdgcn_mfma_f32_32x32x16_bf16(a, s1, o1, 0, 0, 0); }
            { int nn_ = __builtin_amdgcn_readfirstlane(n); asm volatile("" : "+s"(nn_));
#pragma unroll
              for (int r = 0; r < 16; ++r) { const int tau = 32 * tb + at::crow(r, hi), t = dir ? (SEQ - 1 - (64 * nn_ + tau)) : (64 * nn_ + tau); bf16_t* op = O + ((size_t)b * SEQ + t) * HW + colbase + 64 * dh + r32; op[0] = (bf16_t)(pk2(o0[r], 0.f) & 0xffffu); op[32] = (bf16_t)(pk2(o1[r], 0.f) & 0xffffu); } }
        } else {
#pragma unroll
            for (int kt = 0; kt < 4; ++kt)
#pragma unroll
                for (int g = 0; g < 4; ++g) { const f32x4 e = *reinterpret_cast<const LAS f32x4*>(ebl + 32 * kt + 8 * g + 4 * hi); st[kt][4 * g] *= e.x; st[kt][4 * g + 1] *= e.y; st[kt][4 * g + 2] *= e.z; st[kt][4 * g + 3] *= e.w; }
            const int vb = (int)(uintptr_t)(lds + VIMG) + at::v_rd_base(lane) + vt * 512;
#define HG_U(S4) do { const s16x4 L = at::tr_read<at::v_rd_off(0, S4, 0)>(vb), H = at::tr_read<at::v_rd_off(0, S4, 1)>(vb); asm volatile("s_waitcnt lgkmcnt(0)" ::: "memory"); __builtin_amdgcn_sched_barrier(0); \
    const bf16x8 bf = (bf16x8){L[0], L[1], L[2], L[3], H[0], H[1], H[2], H[3]}; \
    _Pragma("unroll") for (int kt = 0; kt < 4; ++kt) { const bf16x8 a = *reinterpret_cast<const LAS bf16x8*>(lds + KTIMG + HG_SWZ128(32 * kt + r32, (16 * (S4) + 8 * hi) * 2)); st[kt] = __builtin_amdgcn_mfma_f32_32x32x16_bf16(a, bf, st[kt], 0, 0, 0); } } while (0)
            HG_U(0); HG_U(1); HG_U(2); HG_U(3);
#undef HG_U
        }
    }
#undef HG_LOAD
}
DEVINL void hgrn_finalize(const Params& p, const float* hgrn_out_g_, int b, int h, int r0, int nrows, int wave, int lane) {
    const bf16_t* OF = (const bf16_t*)(p.ws + WS_OF); const bf16_t* OB = (const bf16_t*)(p.ws + WS_OB); const bf16_t* HGS = (const bf16_t*)(p.ws + WS_HGS); bf16_t* MIX = (bf16_t*)(p.ws + WS_MIXED);
    const int hl = lane >> 5, c4 = 4 * (lane & 31); const f32x4 g = *(const f32x4*)(hgrn_out_g_ + h * 128 + c4);
    for (int rr = 32 * wave; rr < nrows; rr += 32 * NWAVES) {
        u32x2 a[16], c[16], hg[16];
#pragma unroll
        for (int i = 0; i < 16; ++i) { const size_t o = ((size_t)b * SEQ + r0 + rr + 2 * i + hl) * HW + h * 128 + c4; a[i] = __builtin_nontemporal_load((const u32x2*)(OF + o)); c[i] = __builtin_nontemporal_load((const u32x2*)(OB + o)); hg[i] = __builtin_nontemporal_load((const u32x2*)(HGS + o)); }
#pragma unroll
        for (int i = 0; i < 16; ++i) { const f32x4 v = {bf2f(a[i].x & 0xffffu) + bf2f(c[i].x & 0xffffu), bf2f(a[i].x >> 16) + bf2f(c[i].x >> 16), bf2f(a[i].y & 0xffffu) + bf2f(c[i].y & 0xffffu), bf2f(a[i].y >> 16) + bf2f(c[i].y >> 16)};
            float ss = (v.x * v.x + v.y * v.y) + (v.z * v.z + v.w * v.w);
            ss = sum_xor16(row_sum16(ss));
            const float inv = __builtin_amdgcn_rsqf(ss * (1.f / HDV) + EPS); u32x2 w;
            w.x = pk2(v.x * inv * g.x * bf2f(hg[i].x & 0xffffu), v.y * inv * g.y * bf2f(hg[i].x >> 16)); w.y = pk2(v.z * inv * g.z * bf2f(hg[i].y & 0xffffu), v.w * inv * g.w * bf2f(hg[i].y >> 16));
            *(u32x2*)(MIX + ((size_t)b * SEQ + r0 + rr + 2 * i + hl) * DM + h * 128 + c4) = w; }
    }
}
DEVINL void hgrn_chain(const Params& p, LAS char* lds, int chain, const float* hgrn_out_g_, bool fused) {
    const int tid = threadIdx.x, wid = __builtin_amdgcn_readfirstlane(tid >> 6), lane = tid & 63;
    if (wid < 4) hgrn_loop<false>(p, lds, chain, wid, lane); else hgrn_loop<true>(p, lds, chain, wid, lane);
    if (!fused) { __syncthreads(); return; }
    const int b = chain >> 4, dir = (chain >> 3) & 1, h = chain & 7;
    asm volatile("s_waitcnt vmcnt(0)" ::: "memory");
    __syncthreads();
    if (tid == 0) { unsigned* cnt = (unsigned*)(p.ws + WS_CTL) + CW_HGCNT + 64 * (b * 8 + h);
        __builtin_amdgcn_fence(__ATOMIC_RELEASE, "agent"); asm volatile("s_waitcnt vmcnt(0)" ::: "memory");
        __hip_atomic_fetch_add(cnt, 1u, __ATOMIC_RELAXED, __HIP_MEMORY_SCOPE_AGENT); }
    __syncthreads();
}
DEVINL void finalize_pool(const Params& p, const float* hgrn_out_g_, LAS int* slot, int tid, int wave, int lane) {
    unsigned* ctl = (unsigned*)(p.ws + WS_CTL);
    for (;;) {
        __syncthreads();
        if (tid == 0) { const int idx = (int)__hip_atomic_fetch_add(ctl + CW_HGQ, 1u, __ATOMIC_RELAXED, __HIP_MEMORY_SCOPE_AGENT);
            if (idx < NB * HH * 8) { unsigned* cnt = ctl + CW_HGCNT + 64 * (idx >> 3); unsigned sp = 0;
                while (__hip_atomic_load(cnt, __ATOMIC_RELAXED, __HIP_MEMORY_SCOPE_AGENT) < 2u) { __builtin_amdgcn_s_sleep(2); if (++sp > (1u << 22)) break; }
                __builtin_amdgcn_fence(__ATOMIC_ACQUIRE, "agent"); asm volatile("s_waitcnt vmcnt(0)" ::: "memory"); }
            *slot = idx; }
        __syncthreads();
        const int idx = *slot; if (idx >= NB * HH * 8) break;
        const int bh = idx >> 3, part = idx & 7; hgrn_finalize(p, hgrn_out_g_, bh >> 3, bh & 7, part * 256, 256, wave, lane);
    }
}
}

DEVINL void phase6(const Params& p, const float* hgrn_out_g_, int wave, int lane) {
    for (int it = blockIdx.x; it < NB * HH * 8; it += gridDim.x) { const int bh = it >> 3, part = it & 7; hg::hgrn_finalize(p, hgrn_out_g_, bh >> 3, bh & 7, part * 256, 256, wave, lane); }
}

DEVINL f32x4 ld_x1(const unsigned char* ws, int row, int idx4) {
    if (X1_BF16) { const u32x2 w = __builtin_nontemporal_load((const u32x2*)((const bf16_t*)(ws + WS_X1) + (size_t)row * DM) + idx4); return (f32x4){bf2f(w.x & 0xffffu), bf2f(w.x >> 16), bf2f(w.y & 0xffffu), bf2f(w.y >> 16)}; }
    else return __builtin_nontemporal_load((const f32x4*)((const float*)(ws + WS_X1) + (size_t)row * DM) + idx4);
}
DEVINL void phase8(const Params& p, const float* norm2_g_, const float* w_router_, LAS unsigned char* lds, int tid, int wave, int lane) {
    const int gw = blockIdx.x * NWAVES + wave, NGW = gridDim.x * NWAVES;
    const float* MOD = (const float*)(p.ws + WS_MOD); bf16_t* H2 = (bf16_t*)(p.ws + WS_H2); float* AFF = (float*)(p.ws + WS_AFF);
    LAS f32x4* wl = (LAS f32x4*)lds;
    const int rpw = (NTOK + NGW - 1) / NGW, row0 = gw * rpw, row1 = (row0 + rpw < NTOK) ? row0 + rpw : NTOK;
    f32x4 v[8], gm[8], sh[8]; int curb = -1;
    { const int frow = (row0 < NTOK) ? row0 : 0;
#pragma unroll
      for (int j = 0; j < 8; ++j) v[j] = ld_x1(p.ws, frow, lane + 64 * j); }
    for (int j = wave; j < 8; j += NWAVES) {
        const float* src = w_router_ + (size_t)(4 * lane + 256 * j) * NE; f32x4 t[16];
#pragma unroll
        for (int i = 0; i < 16; ++i) t[i] = *(const f32x4*)(src + 4 * i);
#pragma unroll
        for (int i = 0; i < 16; ++i) wl[(i & 3) * 2048 + (4 * j + (i >> 2)) * 64 + lane] = t[i]; }
    __syncthreads();
    for (int row = row0; row < row1; ++row) {
        const int b = row >> 11, s = row & 2047;
        if (b != curb) { curb = b;
#pragma unroll
            for (int j = 0; j < 8; ++j) { const int col = 4 * (lane + 64 * j);
                const f32x4 g = *(const f32x4*)(norm2_g_ + col), sc = *(const f32x4*)(MOD + b * 6 * DM + 4 * DM + col); sh[j] = *(const f32x4*)(MOD + b * 6 * DM + 3 * DM + col); gm[j] = g * (sc + 1.f); } }
        f32x4 nv[8];
        { const int nrow = (row + 1 < row1) ? row + 1 : row;
#pragma unroll
          for (int j = 0; j < 8; ++j) nv[j] = ld_x1(p.ws, nrow, lane + 64 * j); }
        float ss = 0.f;
#pragma unroll
        for (int j = 0; j < 8; ++j) ss += (v[j].x * v[j].x + v[j].y * v[j].y) + (v[j].z * v[j].z + v[j].w * v[j].w);
        const float r = __builtin_amdgcn_rsqf(wave_sum(ss) * (1.f / DM) + EPS);
        f32x4 lg[4];
#pragma unroll
        for (int e = 0; e < 4; ++e) lg[e] = (f32x4){0.f, 0.f, 0.f, 0.f};
        u32x2* o = (u32x2*)(H2 + (size_t)row * DM) + lane;
#pragma unroll
        for (int j = 0; j < 8; ++j) {
            const f32x4 h = v[j] * r * gm[j] + sh[j]; u32x2 w; w.x = pk2(h.x, h.y); w.y = pk2(h.z, h.w); o[64 * j] = w;
#pragma unroll
            for (int q = 0; q < 4; ++q)
#pragma unroll
                for (int e4 = 0; e4 < 4; ++e4) lg[e4] += wl[e4 * 2048 + (4 * j + q) * 64 + lane] * h[q];
            __builtin_amdgcn_sched_barrier(0); }
        float l16[16];
        { float pv[16];
#pragma unroll
          for (int e = 0; e < 16; ++e) pv[e] = lg[e >> 2][e & 3];
          wave_sum16(pv, l16); }
        float mx = l16[0];
#pragma unroll
        for (int e = 1; e < 16; ++e) mx = fmaxf(mx, l16[e]);
        float sum = 0.f;
#pragma unroll
        for (int e = 0; e < 16; ++e) { l16[e] = __expf(l16[e] - mx); sum += l16[e]; }
        const float is = __builtin_amdgcn_rcpf(sum); float mine = 0.f;
#pragma unroll
        for (int e = 0; e < 16; ++e) mine = (lane == e) ? l16[e] * is : mine;
        if (lane < 16) AFF[((size_t)b * NE + lane) * SEQ + s] = mine;
#pragma unroll
        for (int j = 0; j < 8; ++j) v[j] = nv[j];
    }
    __syncthreads();
}

typedef int i32x4 __attribute__((ext_vector_type(4)));
DEVINL int wg_sum9(int c, LAS int* red, int par, int wave, int lane) {
    if (lane == 0) red[par * 8 + wave] = c;
    asm volatile("s_waitcnt lgkmcnt(0)" ::: "memory"); __builtin_amdgcn_s_barrier(); asm volatile("" ::: "memory");
    const LAS int* r = red + par * 8; return (r[0] + r[1]) + (r[2] + r[3]) + (r[4] + r[5]) + (r[6] + r[7]);
}
DEVINL void phase9(const Params& p, LAS unsigned char* lds, int tid, int wave, int lane) {
    const unsigned* AFFB = (const unsigned*)(p.ws + WS_AFF); float* GATE = (float*)(p.ws + WS_GATE); short* INV = (short*)(p.ws + WS_INV); int* SEL = (int*)(p.ws + WS_SEL);
    LAS int* red = (LAS int*)lds;
    for (int be = blockIdx.x; be < NB * NE; be += gridDim.x) {
        const int b = be >> 4, e = be & 15;
        __syncthreads();
        const u32x4 xv = *(const u32x4*)(AFFB + (size_t)be * SEQ + 4 * tid);
        unsigned T = 0u; int par = 0;
#define P9_CNT(cand_) (__builtin_popcountll(__ballot(xv.x >= (cand_))) + __builtin_popcountll(__ballot(xv.y >= (cand_))) + __builtin_popcountll(__ballot(xv.z >= (cand_))) + __builtin_popcountll(__ballot(xv.w >= (cand_))))
        for (int bit = 29; bit >= 1; bit -= 2) {
            const unsigned c1 = T | (1u << bit), c2 = T | (2u << bit), c3 = T | (3u << bit);
            const int n1 = P9_CNT(c1), n2 = P9_CNT(c2), n3 = P9_CNT(c3);
            LAS i32x4* r4 = (LAS i32x4*)(lds + 256) + par * 8;
            if (lane == 0) r4[wave] = (i32x4){n1, n2, n3, 0};
            asm volatile("s_waitcnt lgkmcnt(0)" ::: "memory"); __builtin_amdgcn_s_barrier(); asm volatile("" ::: "memory");
            i32x4 t = r4[0];
#pragma unroll
            for (int w = 1; w < 8; ++w) t += r4[w];
            T = (t.z >= CAP) ? c3 : (t.y >= CAP) ? c2 : (t.x >= CAP) ? c1 : T; par ^= 1; }
        { const unsigned cand = T | 1u; const int c = P9_CNT(cand); if (wg_sum9(c, red, par, wave, lane) >= CAP) T = cand; par ^= 1; }
#undef P9_CNT
        const int cgt = wg_sum9(__builtin_popcountll(__ballot(xv.x > T)) + __builtin_popcountll(__ballot(xv.y > T)) + __builtin_popcountll(__ballot(xv.z > T)) + __builtin_popcountll(__ballot(xv.w > T)), red, par, wave, lane); par ^= 1;
        const int need_eq = CAP - cgt;
        const unsigned xs[4] = {xv.x, xv.y, xv.z, xv.w};
        int eqc = 0;
#pragma unroll
        for (int j = 0; j < 4; ++j) eqc += (xs[j] == T) ? 1 : 0;
        int inc = eqc;
#pragma unroll
        for (int o = 1; o < 64; o <<= 1) { const int t = __shfl_up(inc, o); if (lane >= o) inc += t; }
        LAS int* woff = red + 16;
        if (lane == 63) woff[wave] = inc;
        asm volatile("s_waitcnt lgkmcnt(0)" ::: "memory"); __builtin_amdgcn_s_barrier(); asm volatile("" ::: "memory");
        int eqbase = inc - eqc;
        for (int w = 0; w < wave; ++w) eqbase += woff[w];
        int selc = 0; bool selj[4];
#pragma unroll
        for (int j = 0; j < 4; ++j) { const bool eq = xs[j] == T; selj[j] = (xs[j] > T) || (eq && eqbase < need_eq); eqbase += eq ? 1 : 0; selc += selj[j] ? 1 : 0; }
        int inc2 = selc;
#pragma unroll
        for (int o = 1; o < 64; o <<= 1) { const int t = __shfl_up(inc2, o); if (lane >= o) inc2 += t; }
        if (lane == 63) woff[8 + wave] = inc2;
        asm volatile("s_waitcnt lgkmcnt(0)" ::: "memory"); __builtin_amdgcn_s_barrier(); asm volatile("" ::: "memory");
        int slot = inc2 - selc;
        for (int w = 0; w < wave; ++w) slot += woff[8 + w];
#pragma unroll
        for (int j = 0; j < 4; ++j) { const int s = 4 * tid + j; short inv = -1;
            if (selj[j]) { inv = (short)slot; GATE[(e * 4 + b) * CAP + slot] = __uint_as_float(xs[j]); SEL[(e * 4 + b) * CAP + slot] = s; ++slot; }
            INV[((size_t)b * SEQ + s) * NE + e] = inv; }
    }
}

DEVINL void phase12(const Params& p, float* out_, int wave, int lane) {
    const int gw = blockIdx.x * NWAVES + wave, NGW = gridDim.x * NWAVES;
    const float* MOD = (const float*)(p.ws + WS_MOD); const short* INV = (const short*)(p.ws + WS_INV); const bf16_t* Y = (const bf16_t*)(p.ws + WS_Y);
    for (int row = gw; row < NTOK; row += NGW) {
        const int b = row >> 11; f32x4 acc[8];
        const int myinv = (lane < NE) ? (int)INV[(size_t)row * NE + lane] : -1;
        f32x4* o = (f32x4*)(out_ + (size_t)row * DM) + lane; f32x4 x1[8];
#pragma unroll
        for (int j = 0; j < 8; ++j) { acc[j] = (f32x4){0.f, 0.f, 0.f, 0.f}; x1[j] = ld_x1(p.ws, row, lane + 64 * j); }
#ifdef TPROBE
        float dlt_ = 0.f;
        if (row == 0) { const unsigned long long* ts_ = (const unsigned long long*)(p.ws + WS_CTL + 16384); float T = (TPROBE >= 100 ? (float)(ts_[TPROBE - 100] - ts_[0]) : (float)(ts_[TPROBE + 1] - ts_[TPROBE])) * 0.01f - (float)(TP_OFF); T = T < 0.25f ? 0.25f : T; dlt_ = 0.042f * sqrtf(T); }
#define TP_DLT + dlt_
#else
#define TP_DLT
#endif
        unsigned long long m = __ballot(myinv >= 0);
        while (m) { const int e = __builtin_ctzll(m); m &= m - 1; const int slot = __builtin_amdgcn_readlane(myinv, e);
            const u32x2* y = (const u32x2*)(Y + ((size_t)(e * 4 + b) * CAP + slot) * DM) + lane; u32x2 w[8];
#pragma unroll
            for (int j = 0; j < 8; ++j) w[j] = __builtin_nontemporal_load(y + 64 * j);
#pragma unroll
            for (int j = 0; j < 8; ++j) acc[j] += (f32x4){bf2f(w[j].x & 0xffffu), bf2f(w[j].x >> 16), bf2f(w[j].y & 0xffffu), bf2f(w[j].y >> 16)}; }
#pragma unroll
        for (int j = 0; j < 8; ++j) { const int col = 4 * (lane + 64 * j); const f32x4 g = *(const f32x4*)(MOD + b * 6 * DM + 5 * DM + col); __builtin_nontemporal_store(x1[j] + g * acc[j] TP_DLT, o + 64 * j); }
    }
}

constexpr int NPHASES = 13;
__global__ void __launch_bounds__(NTHR, 2) mk_fwd(Params p) {
    extern __shared__ __attribute__((aligned(16))) unsigned char lds_raw[];
    LAS unsigned char* lds = (LAS unsigned char*)lds_raw;
    const int tid = threadIdx.x, lane = tid & 63, wave = __builtin_amdgcn_readfirstlane(tid >> 6);
    unsigned char* ws = p.ws;
#if MK_ONE_LAUNCH
    if (tid < 16) ((LAS unsigned*)(lds + MISC_OFF))[tid] = 0u;
    __syncthreads();
    XcdBarrier xbar = xcd_barrier_post((unsigned*)(ws + WS_CTL) + CW_BAR, (volatile LAS unsigned*)(lds + MISC_OFF) + 8);
#ifdef TPROBE
    int tsn_ = 1; unsigned long long* ts_ = (unsigned long long*)(ws + WS_CTL + 16384); if (blockIdx.x == 0 && tid == 0) ts_[0] = __builtin_amdgcn_s_memrealtime();
#define SEAM0() do { xcd_barrier(xbar); if (blockIdx.x == 0 && tid == 0) ts_[tsn_] = __builtin_amdgcn_s_memrealtime(); ++tsn_; } while (0)
#define SEAM() SEAM0()
#else
#define SEAM0() xcd_barrier(xbar)
#define SEAM() xcd_barrier(xbar)
#endif
#if GEMM_B3
#define B3_SAVE() const unsigned sv0_ = __builtin_amdgcn_readfirstlane(((volatile LAS unsigned*)(lds + MISC_OFF))[8]), sv1_ = __builtin_amdgcn_readfirstlane(((volatile LAS unsigned*)(lds + MISC_OFF))[9])
#define B3_REST() do { if (tid == 0) { ((volatile LAS unsigned*)(lds + MISC_OFF))[8] = sv0_; ((volatile LAS unsigned*)(lds + MISC_OFF))[9] = sv1_; } } while (0)
#endif
#else
#define SEAM0() do {} while (0)
#define SEAM() do {} while (0)
#endif
#ifndef B3_SAVE
#define B3_SAVE() do {} while (0)
#define B3_REST() do {} while (0)
#endif
#ifdef ONLY_PHASE
#define IN(k) ((k) == ONLY_PHASE)
#else
#ifdef ONLY_PHASE
#define IN(k) ((k) == ONLY_PHASE)
#else
#define IN(k) (p.ph_lo <= (k) && (k) < p.ph_hi)
#endif
#endif
#define BOTH(k) (IN(k) && IN((k) + 1))
#ifndef DUPMASK
#define DUPMASK 0
#endif
#define REP(k) for (int rep_ = 0; rep_ < 1 + ((DUPMASK >> (k)) & 1); ++rep_)
#define DUP_HGRN ((DUPMASK >> 20) & 1)
#define DUP_ATTN ((DUPMASK >> 21) & 1)
#ifndef B3MASK
#define B3MASK 0xFFF7
#endif
#define GEMM_CALL(PH_, DUAL_, EPI_, SCHED_, GATHER_) g8::gemm_sel<(GEMM_B3 && ((B3MASK >> (PH_)) & 1)), DUAL_, EPI_, SCHED_, GATHER_>
    if (IN(0)) { REP(0) { phase0(p, lds, tid, wave, lane); __syncthreads(); } }
    if (IN(1)) {
#if MK_ONE_LAUNCH
        if (IN(0)) {
            if (tid == 0) { unsigned* cnt = (unsigned*)(ws + WS_CTL) + CW_MODCNT; unsigned sp = 0;
                while (__hip_atomic_load(cnt, __ATOMIC_RELAXED, __HIP_MEMORY_SCOPE_AGENT) < (unsigned)GV_EARLY) { __builtin_amdgcn_s_sleep(2); if (++sp > (1u << 22)) break; }
                __builtin_amdgcn_fence(__ATOMIC_ACQUIRE, "agent"); asm volatile("s_waitcnt vmcnt(0)" ::: "memory"); }
            __syncthreads(); }
#endif
        REP(1) phase1(p, wave, lane); if (BOTH(1)) SEAM(); }
#ifndef MFMA_GEMM
#define MFMA_GEMM 1
#endif
#ifndef MFMA_ATTN
#define MFMA_ATTN 1
#endif
#ifndef MFMA_HGRN
#define MFMA_HGRN 1
#endif
    if (IN(2)) { EpiProj E{ws};
#if MFMA_GEMM
        const int ns2 = (gridDim.x >= 256 && CV_P2_END > CV_P0_END) ? NS2 : 0;
        if ((int)blockIdx.x < ns2) { gemv_deferred(p, lds, tid, wave, lane);
            stream_items(p, lds, CW_SQ2, CV_P0_END, CV_P2_END, blockIdx.x, ns2, wave, lane); }
        else { g8::SchedPlain S; S.T.init(NTOK / 256, DINP / 256, gridDim.x - ns2, blockIdx.x - ns2, (DUPMASK >> 2) & 1); S.A = (const bf16_t*)(ws + WS_H); S.Bt = (const bf16_t*)(ws + WS_WIN); S.lda = DM; S.ldb = DM;
            B3_SAVE(); GEMM_CALL(2, false, EpiProj, g8::SchedPlain, false)(lds, DM, DM, DM, S, E); B3_REST(); stream_items(p, lds, CW_SQ2, CV_P0_END, CV_P2_END, 0, 1, wave, lane); }
        if (ns2 == 0) stream_items(p, lds, CW_SQ2, CV_P0_END, CV_P2_END, blockIdx.x, gridDim.x, wave, lane);
#else
        naive_gemm<false>((const bf16_t*)(ws + WS_H), DM, (const bf16_t*)(ws + WS_WIN), nullptr, DM, 0, NTOK, DINP, DM, E, wave, lane);
#endif
        if (BOTH(2)) SEAM(); }
    if (IN(3)) { EpiBf16 Eq{(bf16_t*)(ws + WS_QRAW), 2048}; EpiBf16 Ek{(bf16_t*)(ws + WS_KVRAW), 2048};
#if MFMA_GEMM
        { g8::SchedPlain S; S.T.init(NTOK / 256, 8, gridDim.x, blockIdx.x, (DUPMASK >> 3) & 1); S.A = (const bf16_t*)(ws + WS_CQ); S.Bt = (const bf16_t*)(ws + WS_WQ); S.lda = QLORA; S.ldb = QLORA; B3_SAVE(); GEMM_CALL(3, false, EpiBf16, g8::SchedPlain, false)(lds, QLORA, QLORA, QLORA, S, Eq); B3_REST(); }
        { g8::SchedPlain S; S.T.init(NTOK / 256, 8, gridDim.x, blockIdx.x, (DUPMASK >> 3) & 1); S.A = (const bf16_t*)(ws + WS_CKV); S.Bt = (const bf16_t*)(ws + WS_WKV); S.lda = KVLORA; S.ldb = KVLORA; B3_SAVE(); GEMM_CALL(3, false, EpiBf16, g8::SchedPlain, false)(lds, KVLORA, KVLORA, KVLORA, S, Ek); B3_REST(); }
#else
        naive_gemm<false>((const bf16_t*)(ws + WS_CQ), QLORA, (const bf16_t*)(ws + WS_WQ), nullptr, QLORA, 0, NTOK, 2048, QLORA, Eq, wave, lane);
        naive_gemm<false>((const bf16_t*)(ws + WS_CKV), KVLORA, (const bf16_t*)(ws + WS_WKV), nullptr, KVLORA, 0, NTOK, 2048, KVLORA, Ek, wave, lane);
#endif
        if (BOTH(3)) SEAM(); }
    if (IN(4)) { { const int* pos_ = (const int*)kaptr(KAOFF(pos)); const float* qg = (const float*)kaptr(KAOFF(q_head_g)); const float* kg = (const float*)kaptr(KAOFF(k_head_g)); REP(4) phase4(p, pos_, qg, kg, wave, lane); } if (BOTH(4)) SEAM(); }
    if (IN(5)) {
#if MFMA_HGRN
        if (gridDim.x >= 256) { if (blockIdx.x < 64) hg::hgrn_chain(p, (LAS char*)lds, blockIdx.x, (const float*)kaptr(KAOFF(hgrn_out_g)), HG_FUSED != 0); else if (blockIdx.x < 128) stream_items(p, lds, CW_SQ5, CV_P2_END, CONV_END5, blockIdx.x - 64, 64, wave, lane); }
        else { for (int ch = blockIdx.x; ch < 64; ch += gridDim.x) hg::hgrn_chain(p, (LAS char*)lds, ch, nullptr, false); stream_items(p, lds, CW_SQ5, CV_P2_END, CONV_END5, blockIdx.x, gridDim.x, wave, lane); }
        __syncthreads();
#else
        hgrn_naive(p, lds, tid); __syncthreads();
#endif
        if (DUP_HGRN) { for (int ch = blockIdx.x; ch < 64; ch += gridDim.x) hg::hgrn_chain(p, (LAS char*)lds, ch, nullptr, false); } if (DUP_ATTN) { at::attn_phase(p, lds); __syncthreads(); }
#if MFMA_ATTN
        at::attn_phase(p, lds);
#else
        attn_naive(p, lds, wave, lane);
#endif
        if (HG_FUSED && MK_ONE_LAUNCH && gridDim.x >= 256) { hg::finalize_pool(p, (const float*)kaptr(KAOFF(hgrn_out_g)), (LAS int*)(lds + MISC_OFF + 128), tid, wave, lane);
            if (blockIdx.x < 64 || blockIdx.x >= 128) { __syncthreads(); stream_items(p, lds, CW_SQ5, CV_P2_END, CONV_END5, 0, 1, wave, lane); } }
        if (BOTH(5)) SEAM(); }
    if (IN(6) && !(HG_FUSED && MK_ONE_LAUNCH && gridDim.x >= 256)) { { const float* hg_ = (const float*)kaptr(KAOFF(hgrn_out_g)); REP(6) phase6(p, hg_, wave, lane); } if (BOTH(6)) SEAM(); }
    if (IN(7)) { EpiOut E{(const float*)kaptr(KAOFF(x)), (const float*)(ws + WS_MOD), (float*)(ws + WS_X1)};
#if MFMA_GEMM
        g8::SchedPlain S; S.T.init(NTOK / 256, DM / 256, gridDim.x, blockIdx.x, (DUPMASK >> 7) & 1); S.A = (const bf16_t*)(ws + WS_MIXED); S.Bt = (const bf16_t*)(ws + WS_WOUT); S.lda = DM; S.ldb = DM;
        B3_SAVE(); GEMM_CALL(7, false, EpiOut, g8::SchedPlain, false)(lds, DM, DM, DM, S, E); B3_REST();
#else
        naive_gemm<false>((const bf16_t*)(ws + WS_MIXED), DM, (const bf16_t*)(ws + WS_WOUT), nullptr, DM, 0, NTOK, DM, DM, E, wave, lane);
#endif
        if (BOTH(7)) SEAM(); }
    if (IN(8)) { { const float* n2 = (const float*)kaptr(KAOFF(norm2_g)); const float* wr_ = (const float*)kaptr(KAOFF(w_router)); REP(8) phase8(p, n2, wr_, lds, tid, wave, lane); } if (BOTH(8)) SEAM(); }
    if (IN(9)) { REP(9) { phase9(p, lds, tid, wave, lane); __syncthreads(); } if (BOTH(9)) SEAM(); }
    if (IN(10)) { EpiSwiglu E{(bf16_t*)(ws + WS_HMID)};
#if MFMA_GEMM
        g8::SchedExpDual S; S.T.init(NSLOTROWS / 256, FF / 128, gridDim.x, blockIdx.x, (DUPMASK >> 10) & 1); S.A = (const bf16_t*)(ws + WS_H2); S.Wg = (const bf16_t*)(ws + WS_WG); S.Wu = (const bf16_t*)(ws + WS_WU); S.SEL = (const int*)(ws + WS_SEL);
        B3_SAVE(); GEMM_CALL(10, true, EpiSwiglu, g8::SchedExpDual, true)(lds, DM, DM, DM, S, E); B3_REST();
#else
        naive_gemm<true>((const bf16_t*)(ws + WS_XE), DM, (const bf16_t*)(ws + WS_WG), (const bf16_t*)(ws + WS_WU), DM, (size_t)FF * DM, NSLOTROWS, FF, DM, E, wave, lane);
#endif
        if (BOTH(10)) SEAM(); }
    if (IN(11)) { EpiDown E{(bf16_t*)(ws + WS_Y), (const float*)(ws + WS_GATE)};
#if MFMA_GEMM
        g8::SchedExpDown S; S.T.init(NSLOTROWS / 256, DM / 256, gridDim.x, blockIdx.x, (DUPMASK >> 11) & 1); S.A = (const bf16_t*)(ws + WS_HMID); S.Wd = (const bf16_t*)(ws + WS_WD);
        B3_SAVE(); GEMM_CALL(11, false, EpiDown, g8::SchedExpDown, false)(lds, FF, FF, FF, S, E); B3_REST();
#else
        naive_gemm<false>((const bf16_t*)(ws + WS_HMID), FF, (const bf16_t*)(ws + WS_WD), nullptr, FF, (size_t)DM * FF, NSLOTROWS, DM, FF, E, wave, lane);
#endif
        if (BOTH(11)) SEAM(); }
    if (IN(12)) { { float* out_ = (float*)kaptr(KAOFF(out)); REP(12) phase12(p, out_, wave, lane); } }
#undef IN
#undef BOTH
}

extern "C" void kernel_launch(void* const* d_in, const int* in_sizes, int n_in, void* d_out, int out_size, void* d_ws, size_t ws_size, hipStream_t stream) {
    static int grid = 0;
    if (grid == 0) {
        if (n_in != 21 || in_sizes[0] != NTOK * DM || out_size != NTOK * DM || ws_size < WS_END) { fprintf(stderr, "kernel_launch: unexpected shapes (n_in %d, in0 %d, out %d, ws %zu < %zu)\n", n_in, n_in > 0 ? in_sizes[0] : -1, out_size, ws_size, (size_t)WS_END); grid = -1; return; }
        int dev = 0, cus = 0, per_cu = 0;
        if (hipGetDevice(&dev) != hipSuccess || hipDeviceGetAttribute(&cus, hipDeviceAttributeMultiprocessorCount, dev) != hipSuccess) { grid = -1; return; }
        if (hipFuncSetAttribute((const void*)mk_fwd, hipFuncAttributeMaxDynamicSharedMemorySize, LDS_BYTES) != hipSuccess) { fprintf(stderr, "kernel_launch: hipFuncSetAttribute failed\n"); grid = -1; return; }
        if (hipOccupancyMaxActiveBlocksPerMultiprocessor(&per_cu, (const void*)mk_fwd, NTHR, LDS_BYTES) != hipSuccess || per_cu < 1) { fprintf(stderr, "kernel_launch: occupancy query says %d blocks per CU\n", per_cu); per_cu = 1; }
        (void)hipGetLastError();
        grid = cus;
    }
    if (grid < 0) return;
    (void)hipMemsetAsync((char*)d_ws + WS_CTL, 0, CTL_ZERO_BYTES, stream);
    Params p{};
    p.x = (const float*)d_in[0]; p.c = (const float*)d_in[1]; p.pos = (const int*)d_in[2]; p.w_ada = (const float*)d_in[3]; p.b_ada = (const float*)d_in[4]; p.norm1_g = (const float*)d_in[5];
    p.w_in = (const float*)d_in[6]; p.lb_logits = (const float*)d_in[7]; p.hgrn_out_g = (const float*)d_in[8]; p.qa_norm_g = (const float*)d_in[9]; p.w_uq = (const float*)d_in[10]; p.kva_norm_g = (const float*)d_in[11];
    p.w_ukv = (const float*)d_in[12]; p.q_head_g = (const float*)d_in[13]; p.k_head_g = (const float*)d_in[14]; p.w_out = (const float*)d_in[15]; p.norm2_g = (const float*)d_in[16]; p.w_router = (const float*)d_in[17];
    p.w_gate = (const float*)d_in[18]; p.w_up = (const float*)d_in[19]; p.w_down = (const float*)d_in[20]; p.out = (float*)d_out; p.ws = (unsigned char*)d_ws;
#if MK_ONE_LAUNCH
    p.ph_lo = 0; p.ph_hi = NPHASES;
    void* args[] = {&p};
    hipError_t e = hipLaunchCooperativeKernel((const void*)mk_fwd, dim3(grid), dim3(NTHR), args, LDS_BYTES, stream);
    if (e != hipSuccess) fprintf(stderr, "kernel_launch: cooperative launch failed: %s (grid %d)\n", hipGetErrorString(e), grid);
#else
    for (int ph = 0; ph < NPHASES; ++ph) { p.ph_lo = ph; p.ph_hi = ph + 1; hipLaunchKernelGGL(mk_fwd, dim3(grid), dim3(NTHR), LDS_BYTES, stream, p); }
    const hipError_t le = hipPeekAtLastError(); if (le != hipSuccess) fprintf(stderr, "kernel_launch: launch failed: %s\n", hipGetErrorName(le));
#endif
}
```
